# Optimizing an MI355X kernel written in HIP

```python
import jax, jax.numpy as jnp
from jax import lax
import numpy as np

D_MODEL = 2048
BATCH = 2
SEQ = 8192
DEPTH = 2

CHUNK = 64
Q_BLOCK = 128
N_MEM = 256
D_FF = 5632
CONV_CH = D_MODEL // 2
CONV_WIDTH = 31
MLA_HEADS = 8
QK_NOPE = 128
QK_ROPE = 64
QK_HEAD = QK_NOPE + QK_ROPE
V_HEAD = 128
Q_LORA = 768
KV_LORA = 256
ROPE_THETA = 10000.0
X_HEADS = 4
X_HEAD_DIM = D_MODEL // X_HEADS
IN_COLS = 2 * CONV_CH + Q_LORA + KV_LORA + QK_ROPE
MIX_OUT = CONV_CH + MLA_HEADS * V_HEAD
EPS = 1e-6
NEG_INF = -1e30

kernel_name = "hybrid_conv_mla_macaron_encoder"


def rms_norm(x, g):
    xf = x.astype(jnp.float32)
    y = xf * lax.rsqrt(jnp.mean(xf * xf, axis=-1, keepdims=True) + EPS)
    return (y * g.astype(jnp.float32)).astype(x.dtype)


def layer_norm(x, g, b):
    xf = x.astype(jnp.float32)
    mu = jnp.mean(xf, axis=-1, keepdims=True)
    var = jnp.mean(jnp.square(xf - mu), axis=-1, keepdims=True)
    y = (xf - mu) * lax.rsqrt(var + EPS)
    return (y * g.astype(jnp.float32) + b.astype(jnp.float32)).astype(x.dtype)


def swiglu_ffn(x, norm_g, w_gate, w_up, w_down):
    h = rms_norm(x, norm_g)
    return (jax.nn.silu(h @ w_gate) * (h @ w_up)) @ w_down


def rope_tables(positions):
    inv_freq = 1.0 / (ROPE_THETA ** (jnp.arange(0, QK_ROPE, 2, dtype=jnp.float32) / QK_ROPE))
    ang = positions.astype(jnp.float32)[..., None] * inv_freq
    return jnp.cos(ang)[:, :, None, :], jnp.sin(ang)[:, :, None, :]


def apply_rope(x, cos, sin):
    c = cos.astype(x.dtype)
    s = sin.astype(x.dtype)
    x1, x2 = x[..., : QK_ROPE // 2], x[..., QK_ROPE // 2:]
    return jnp.concatenate([x1 * c - x2 * s, x2 * c + x1 * s], axis=-1)


def conv_module(u, conv_w, conv_b, ln_g, ln_b):
    a = u[..., :CONV_CH] * jax.nn.sigmoid(u[..., CONV_CH:])
    y = lax.conv_general_dilated(
        a, conv_w[:, None, :], window_strides=(1,),
        padding=[(CONV_WIDTH - 1, 0)],
        dimension_numbers=("NWC", "WIO", "NWC"),
        feature_group_count=CONV_CH) + conv_b
    return jax.nn.silu(layer_norm(y, ln_g, ln_b))


def chunk_causal_attention(q, k, v):
    B, S, H, Dq = q.shape
    Dv = v.shape[-1]
    nb = S // Q_BLOCK
    scale = Dq ** -0.5
    key_chunk = jnp.arange(S) // CHUNK
    qb = q.reshape(B, nb, Q_BLOCK, H, Dq).transpose(1, 0, 2, 3, 4)

    def one_block(args):
        qi, i = args
        s = jnp.einsum("bqhd,bkhd->bhqk", qi, k).astype(jnp.float32) * scale
        q_chunk = (i * Q_BLOCK + jnp.arange(Q_BLOCK)) // CHUNK
        mask = key_chunk[None, :] <= q_chunk[:, None]
        s = jnp.where(mask[None, None], s, NEG_INF)
        p = jax.nn.softmax(s, axis=-1).astype(v.dtype)
        return jnp.einsum("bhqk,bkhd->bqhd", p, v)

    out = lax.map(one_block, (qb, jnp.arange(nb)))
    return out.transpose(1, 0, 2, 3, 4).reshape(B, S, H, Dv)


def mla_group(c_q, c_kv, k_pe, cos, sin, q_a_norm, w_q_b, kv_a_norm, w_kv_b, q_norm, k_norm):
    B, S, _ = c_q.shape
    q = (rms_norm(c_q, q_a_norm) @ w_q_b).reshape(B, S, MLA_HEADS, QK_HEAD)
    kv = (rms_norm(c_kv, kv_a_norm) @ w_kv_b).reshape(B, S, MLA_HEADS, QK_NOPE + V_HEAD)
    k_nope, v = kv[..., :QK_NOPE], kv[..., QK_NOPE:]
    k = jnp.concatenate(
        [k_nope, jnp.broadcast_to(k_pe[:, :, None, :], (B, S, MLA_HEADS, QK_ROPE))], axis=-1)
    q = rms_norm(q, q_norm)
    k = rms_norm(k, k_norm)
    q = jnp.concatenate([q[..., :QK_NOPE], apply_rope(q[..., QK_NOPE:], cos, sin)], axis=-1)
    k = jnp.concatenate([k[..., :QK_NOPE], apply_rope(k[..., QK_NOPE:], cos, sin)], axis=-1)
    o = chunk_causal_attention(q, k, v)
    return o.reshape(B, S, MLA_HEADS * V_HEAD)


def memory_cross_attention(x, mem, cross_norm, mem_norm, w_cq, w_ck, w_cv, cq_norm, ck_norm, w_co):
    B, S, D = x.shape
    M = mem.shape[1]
    h = rms_norm(x, cross_norm)
    m = rms_norm(mem, mem_norm)
    q = rms_norm((h @ w_cq).reshape(B, S, X_HEADS, X_HEAD_DIM), cq_norm)
    k = rms_norm((m @ w_ck).reshape(B, M, X_HEADS, X_HEAD_DIM), ck_norm)
    v = (m @ w_cv).reshape(B, M, X_HEADS, X_HEAD_DIM)
    s = jnp.einsum("bqhd,bmhd->bhqm", q, k).astype(jnp.float32) * (X_HEAD_DIM ** -0.5)
    p = jax.nn.softmax(s, axis=-1).astype(v.dtype)
    o = jnp.einsum("bhqm,bmhd->bqhd", p, v).reshape(B, S, D)
    return o @ w_co


def setup_inputs(seed: int = 0) -> dict:
    key = jax.random.key(seed)
    ks = iter(jax.random.split(key, 64))
    L = DEPTH

    def nrm(shape):
        return jax.random.normal(next(ks), shape, jnp.float32)

    def w(shape, fan_in):
        return nrm(shape) * (fan_in ** -0.5)

    def gain(shape):
        return 1.0 + 0.02 * nrm(shape)

    def bias(shape):
        return 0.02 * nrm(shape)

    x = nrm((BATCH, SEQ, D_MODEL))
    mem = nrm((BATCH, N_MEM, D_MODEL))
    offs = jax.random.randint(next(ks), (BATCH,), 0, 1024) * CHUNK
    positions = (offs[:, None] + jnp.arange(SEQ)[None, :]).astype(jnp.int32)
    return {
        "x": x,
        "mem": mem,
        "positions": positions,
        "ffn1_norm": gain((L, D_MODEL)),
        "ffn1_w_gate": w((L, D_MODEL, D_FF), D_MODEL),
        "ffn1_w_up": w((L, D_MODEL, D_FF), D_MODEL),
        "ffn1_w_down": w((L, D_FF, D_MODEL), D_FF),
        "mix_norm": gain((L, D_MODEL)),
        "w_in": w((L, D_MODEL, IN_COLS), D_MODEL),
        "conv_w": w((L, CONV_WIDTH, CONV_CH), CONV_WIDTH),
        "conv_b": bias((L, CONV_CH)),
        "conv_ln_g": gain((L, CONV_CH)),
        "conv_ln_b": bias((L, CONV_CH)),
        "q_a_norm": gain((L, Q_LORA)),
        "w_q_b": w((L, Q_LORA, MLA_HEADS * QK_HEAD), Q_LORA),
        "kv_a_norm": gain((L, KV_LORA)),
        "w_kv_b": w((L, KV_LORA, MLA_HEADS * (QK_NOPE + V_HEAD)), KV_LORA),
        "q_norm": gain((L, QK_HEAD)),
        "k_norm": gain((L, QK_HEAD)),
        "w_out": w((L, MIX_OUT, D_MODEL), MIX_OUT),
        "cross_norm": gain((L, D_MODEL)),
        "mem_norm": gain((L, D_MODEL)),
        "w_cq": w((L, D_MODEL, D_MODEL), D_MODEL),
        "w_ck": w((L, D_MODEL, D_MODEL), D_MODEL),
        "w_cv": w((L, D_MODEL, D_MODEL), D_MODEL),
        "cq_norm": gain((L, X_HEAD_DIM)),
        "ck_norm": gain((L, X_HEAD_DIM)),
        "w_co": w((L, D_MODEL, D_MODEL), D_MODEL),
        "ffn2_norm": gain((L, D_MODEL)),
        "ffn2_w_gate": w((L, D_MODEL, D_FF), D_MODEL),
        "ffn2_w_up": w((L, D_MODEL, D_FF), D_MODEL),
        "ffn2_w_down": w((L, D_FF, D_MODEL), D_FF),
    }


def reference(x, mem, positions,
              ffn1_norm, ffn1_w_gate, ffn1_w_up, ffn1_w_down,
              mix_norm, w_in, conv_w, conv_b, conv_ln_g, conv_ln_b,
              q_a_norm, w_q_b, kv_a_norm, w_kv_b, q_norm, k_norm, w_out,
              cross_norm, mem_norm, w_cq, w_ck, w_cv, cq_norm, ck_norm, w_co,
              ffn2_norm, ffn2_w_gate, ffn2_w_up, ffn2_w_down):
    cos, sin = rope_tables(positions)
    o_q = 2 * CONV_CH
    o_kv = o_q + Q_LORA
    o_pe = o_kv + KV_LORA
    for l in range(DEPTH):
        x = x + 0.5 * swiglu_ffn(x, ffn1_norm[l], ffn1_w_gate[l], ffn1_w_up[l], ffn1_w_down[l])

        h = rms_norm(x, mix_norm[l])
        z = h @ w_in[l]
        y_conv = conv_module(z[..., :o_q], conv_w[l], conv_b[l], conv_ln_g[l], conv_ln_b[l])
        y_mla = mla_group(z[..., o_q:o_kv], z[..., o_kv:o_pe], z[..., o_pe:], cos, sin,
                          q_a_norm[l], w_q_b[l], kv_a_norm[l], w_kv_b[l], q_norm[l], k_norm[l])
        x = x + jnp.concatenate([y_conv, y_mla], axis=-1) @ w_out[l]

        x = x + memory_cross_attention(x, mem, cross_norm[l], mem_norm[l], w_cq[l], w_ck[l],
                                       w_cv[l], cq_norm[l], ck_norm[l], w_co[l])

        x = x + 0.5 * swiglu_ffn(x, ffn2_norm[l], ffn2_w_gate[l], ffn2_w_up[l], ffn2_w_down[l])
    return x
```

```cpp
#include <hip/hip_runtime.h>
#include <hip/hip_cooperative_groups.h>
#include <cstdio>
#include <cstdint>
namespace cg = cooperative_groups;

#define LAS __attribute__((address_space(3)))
typedef unsigned short bf16_t;
typedef short bf16x8 __attribute__((ext_vector_type(8)));
typedef short s16x4 __attribute__((ext_vector_type(4)));
typedef float f32x4 __attribute__((ext_vector_type(4)));
typedef float f32x16 __attribute__((ext_vector_type(16)));
typedef unsigned u32x4 __attribute__((ext_vector_type(4)));
typedef unsigned u32x2 __attribute__((ext_vector_type(2)));

constexpr int M = 16384, DM = 2048, DFF = 5632, SEQ = 8192, NMEM = 256, MMEM = 512;
constexpr int NIN = 3136, NINP = 3328;
constexpr float EPS = 1e-6f;
constexpr float LOG2E = 1.4426950408889634f;
constexpr float QSCALE = 0.07216878364870322f * LOG2E;
constexpr float XSCALE = 0.04419417382415922f * LOG2E;

constexpr size_t MiB = 1u << 20;
constexpr size_t WS_SSQ = 0;
constexpr size_t WS_W = 2 * MiB, LW = 190 * MiB;
constexpr size_t W_GU1 = 0, W_D1 = 44 * MiB, W_IN = 66 * MiB, W_QB = 79 * MiB, W_KVB = 82 * MiB, W_OUT = 83 * MiB, W_CQ = 91 * MiB,
                 W_CKV = 99 * MiB, W_CO = 115 * MiB, W_GU2 = 123 * MiB, W_D2 = 167 * MiB;
constexpr size_t WS_XB = 382 * MiB, WS_H = 446 * MiB, WS_KVR = 622 * MiB, WS_MIX = 686 * MiB, WS_MEMB = 750 * MiB, WS_KC = 752 * MiB,
                 WS_VT = 756 * MiB, WS_END = 760 * MiB;
constexpr size_t H_AGLU = 0, H_CQ = 32 * MiB, H_CKV = 56 * MiB, H_KPE = 64 * MiB, H_QF = 66 * MiB, H_KF = 114 * MiB;
constexpr size_t H_QC = 0, H_PC = 64 * MiB, H_OC = 96 * MiB;
constexpr int Z_CQ = 8 * M, Z_CKV = 10 * M, Z_QC = 12 * M, Z_KC = 20 * M, ZERO_COUNT = 20 * M + 4096, NZ_X0 = ZERO_COUNT, NZ_MEM = ZERO_COUNT + M;
__device__ __forceinline__ int ssqx(int s) { return s == 0 ? NZ_X0 : (s - 1) * M; }

constexpr size_t WS_PAR = 1536 * 1024;
constexpr int PAR_POS = 0, PAR_L0 = 16384, PAR_LS = 36864, PAR_CONVW = 0, PAR_CONVB = 31744, PAR_LNG = 32768, PAR_LNB = 33792, PAR_QN = 34816, PAR_KN = 35008, PAR_CQN = 35200, PAR_CKN = 35712;
constexpr int LDS_BYTES = 147456;

__device__ __forceinline__ unsigned cvt_pk_bf16(float lo, float hi) { unsigned r; asm volatile("v_cvt_pk_bf16_f32 %0, %1, %2" : "=v"(r) : "v"(lo), "v"(hi)); return r; }
__device__ __forceinline__ float bf_lo(unsigned w) { return __uint_as_float(w << 16); }
__device__ __forceinline__ float bf_hi(unsigned w) { return __uint_as_float(w & 0xffff0000u); }
__device__ __forceinline__ float bf2f(bf16_t v) { return __uint_as_float(((unsigned)v) << 16); }
__device__ __forceinline__ float wave_sum(float v) {
#pragma unroll
    for (int o = 1; o < 64; o <<= 1) v += __shfl_xor(v, o);
    return v;
}
__device__ __forceinline__ float rstd_of(float ssq, float inv_n) { return __builtin_amdgcn_rsqf(ssq * inv_n + EPS); }
__device__ __forceinline__ float sigmoidf_(float g) { return __builtin_amdgcn_rcpf(1.0f + __builtin_amdgcn_exp2f(-g * LOG2E)); }
__device__ __forceinline__ float siluf_(float g) { return g * sigmoidf_(g); }
#define LDS_WAIT() asm volatile("s_waitcnt lgkmcnt(0)" ::: "memory")
#define VM_WAIT() asm volatile("s_waitcnt vmcnt(0)" ::: "memory")

namespace pg8 {
constexpr int BM = 256, BK = 64, HALF = 128, HTB = HALF * BK * 2, STAGE_BYTES = 8 * HTB, NXCD = 8, WGM = 8;
__host__ __device__ __forceinline__ int lds_byte(int r, int c) { const int st = (r >> 4) * 2 + (c >> 5), rr = r & 15, cc = c & 31, ob = rr * 64 + cc * 2; return st * 1024 + (ob ^ (((ob >> 9) & 1) << 5)); }
__host__ __device__ __forceinline__ void stage_rc(int b, int& R, int& C) { const int st = b / 1024, sb = b % 1024, swz = sb ^ (((sb >> 9) & 1) << 5); R = (st >> 1) * 16 + swz / 64; C = (st & 1) * 32 + (swz % 64) / 2; }
__host__ __device__ __forceinline__ int perm32(int rho) { const int n = rho >> 4, i = rho & 15; return 8 * (i >> 2) + 4 * n + (i & 3); }

struct Unit { int pm, pn; };
struct Gemm { const bf16_t* A; const bf16_t* Bt; int lda, ldb, K, mode; };
__device__ __forceinline__ void unit_ptrs(const Gemm& g, const Unit& u, const char*& pa, const char*& pb) {
    size_t ao, bo;
    if (g.mode == 0) { ao = (size_t)u.pm * 256 * g.lda; bo = (size_t)u.pn * 256 * g.ldb; }
    else if (g.mode == 1) { ao = (size_t)u.pm * 256 * g.lda + (size_t)u.pn * 512; bo = (size_t)(u.pm >> 5) * 256 * g.ldb + (size_t)u.pn * 512; }
    else { const int h = u.pn >> 1, dt = u.pn & 1; ao = (size_t)u.pm * 256 * g.lda + (size_t)h * 256; bo = (size_t)((((u.pm >> 5) * 4 + h) * 512) + dt * 256) * g.ldb; }
    pa = (const char*)g.A + ao * 2; pb = (const char*)g.Bt + bo * 2;
}
struct Order {
    int nM, nN, nwg, G, c;
    __device__ __forceinline__ void init(int nM_, int nN_, int G_, int c_) { nM = nM_; nN = nN_; nwg = nM * nN; G = G_; c = c_; }
    __device__ __forceinline__ bool next(int i, Unit& u) const {
        const long L = (long)i * G + c; if (L >= nwg) return false;
        int wgid = (int)L; { const int q = nwg / NXCD, r = nwg % NXCD, xcd = wgid % NXCD, off = wgid / NXCD; wgid = (xcd < r ? xcd * (q + 1) : r * (q + 1) + (xcd - r) * q) + off; }
        const int nig = WGM * nN, gid = wgid / nig, fm = gid * WGM, gsz = (nM - fm) < WGM ? (nM - fm) : WGM;
        u.pm = fm + ((wgid % nig) % gsz); u.pn = (wgid % nig) / gsz; return true;
    }
};
struct SingleOrder {
    Unit u0;
    __device__ __forceinline__ bool next(int i, Unit& u) const { if (i != 0) return false; u = u0; return true; }
};

template <class Epi, class Sched, bool ALIGN_EPI, bool SP2>
__device__ __forceinline__ void gemm_phase(LAS unsigned char* lds, const Gemm g, const Sched& S, const Epi& E) {
    int tid_ = threadIdx.x; asm volatile("" : "+v"(tid_));
    const int tid = tid_, wid = __builtin_amdgcn_readfirstlane(tid >> 6), lane = tid & 63, wr = wid >> 2, wc = wid & 3, fr = lane & 15, fq = lane >> 4;
    const int K = g.K, nt = K / BK;
    unsigned voffA[2], voffB[2];
#pragma unroll
    for (int i = 0; i < 2; ++i) { int R, C; stage_rc(tid * 16 + i * 8192, R, C); const int Rb = Epi::PERM ? ((R & ~31) + perm32(R & 31)) : R;
        voffA[i] = (unsigned)(R * g.lda + C) * 2u; voffB[i] = (unsigned)(Rb * g.ldb + C) * 2u; }
    const size_t kstep = (size_t)(BK * 2);
    const size_t hstepA = (size_t)HALF * g.lda * 2, hstepB = (size_t)HALF * g.ldb * 2;
    const unsigned ldsw = (unsigned)wid * 1024u;
    const int aoff = lds_byte(wr * 64 + fr, fq * 8), boff = lds_byte(wc * 32 + fr, fq * 8);
#define PG8_SA(b, h) (((b) * 2 + (h)) * HTB)
#define PG8_SB(b, h) ((4 + (b) * 2 + (h)) * HTB)
#define PG8_STAGE(bufoff, gbase, voff) do { _Pragma("unroll") for (int _i = 0; _i < 2; ++_i) \
        __builtin_amdgcn_global_load_lds((const unsigned*)((const char*)(gbase) + (voff)[_i]), (LAS unsigned*)(lds + (bufoff) + ldsw + _i * 8192), 16, 0, 0); } while (0)
#define PG8_LDA(dst, b, h) do { _Pragma("unroll") for (int m = 0; m < 4; ++m) _Pragma("unroll") for (int k = 0; k < 2; ++k) dst[m][k] = *(const LAS bf16x8*)(lds + PG8_SA(b, h) + aoff + m * 2048 + k * 1024); } while (0)
#define PG8_LDB(dst, b, h) do { _Pragma("unroll") for (int n = 0; n < 2; ++n) _Pragma("unroll") for (int k = 0; k < 2; ++k) dst[n][k] = *(const LAS bf16x8*)(lds + PG8_SB(b, h) + boff + n * 2048 + k * 1024); } while (0)
#define PG8_MMA(ai, bj, At, Bt) do { __builtin_amdgcn_s_setprio(1); _Pragma("unroll") for (int m = 0; m < 4; ++m) _Pragma("unroll") for (int n = 0; n < 2; ++n) _Pragma("unroll") for (int k = 0; k < 2; ++k) \
        acc[ai][bj][m][n] = __builtin_amdgcn_mfma_f32_16x16x32_bf16(Bt[n][k], At[m][k], acc[ai][bj][m][n], 0, 0, 0); __builtin_amdgcn_s_setprio(0); } while (0)
#define PG8_WAIT_V(n) asm volatile("s_waitcnt vmcnt(" #n ")" ::: "memory")
#define PG8_WAIT_L(n) asm volatile("s_waitcnt lgkmcnt(" #n ")" ::: "memory")
#define PG8_BAR __builtin_amdgcn_s_barrier()
#define PG8_SCHED __builtin_amdgcn_sched_barrier(0)
    Unit cur, nxt; int ui = 0;
    if (!S.next(0, cur)) return;
    f32x4 acc[2][2][4][2];
#pragma unroll
    for (int a = 0; a < 2; ++a)
#pragma unroll
        for (int b = 0; b < 2; ++b)
#pragma unroll
            for (int m = 0; m < 4; ++m)
#pragma unroll
                for (int n = 0; n < 2; ++n) acc[a][b][m][n] = (f32x4){0.f, 0.f, 0.f, 0.f};
    bf16x8 At[4][2], B0[2][2], B1[2][2];
    const char* cA; const char* cB; unit_ptrs(g, cur, cA, cB);
    if constexpr (SP2) {
        PG8_STAGE(PG8_SB(0, 0), cB, voffB); PG8_STAGE(PG8_SB(0, 1), cB + hstepB, voffB); PG8_STAGE(PG8_SA(0, 0), cA, voffA); PG8_STAGE(PG8_SA(0, 1), cA + hstepA, voffA);
        if (wr == 1) PG8_BAR;
        PG8_WAIT_V(2); PG8_BAR;
        PG8_STAGE(PG8_SB(1, 0), cB + kstep, voffB); PG8_STAGE(PG8_SA(1, 0), cA + kstep, voffA); PG8_STAGE(PG8_SB(1, 1), cB + hstepB + kstep, voffB);
        PG8_WAIT_V(6); PG8_BAR;
    } else {
        PG8_STAGE(PG8_SB(0, 0), cB, voffB); PG8_STAGE(PG8_SA(0, 0), cA, voffA); PG8_STAGE(PG8_SB(0, 1), cB + hstepB, voffB); PG8_STAGE(PG8_SA(0, 1), cA + hstepA, voffA);
        if (wr == 1) PG8_BAR;
        PG8_WAIT_V(4); PG8_BAR;
        PG8_STAGE(PG8_SB(1, 0), cB + kstep, voffB); PG8_STAGE(PG8_SA(1, 0), cA + kstep, voffA); PG8_STAGE(PG8_SB(1, 1), cB + hstepB + kstep, voffB);
        PG8_WAIT_V(6); PG8_BAR;
    }
    for (;;) {
        const bool has_next = S.next(ui + 1, nxt);
        const char* nA = cA; const char* nB = cB; if (has_next) unit_ptrs(g, nxt, nA, nB);
        for (int t = 0; t < nt; t += 2) {
            const bool last = (t == nt - 2);
            const char* a1 = cA + (size_t)(t + 1) * kstep;
            const char* a2 = last ? nA : cA + (size_t)(t + 2) * kstep; const char* b2 = last ? nB : cB + (size_t)(t + 2) * kstep;
            const char* a3 = a2 + kstep; const char* b3 = b2 + kstep;
            if constexpr (SP2) {
            PG8_LDB(B0, 0, 0); PG8_LDB(B1, 0, 1); PG8_SCHED; PG8_LDA(At, 0, 0); PG8_STAGE(PG8_SA(1, 1), a1 + hstepA, voffA);
            PG8_WAIT_V(8); PG8_WAIT_L(0); PG8_BAR; PG8_MMA(0, 0, At, B0); PG8_MMA(0, 1, At, B1); PG8_BAR; PG8_SCHED;
            PG8_LDA(At, 0, 1); PG8_STAGE(PG8_SB(0, 0), b2, voffB); PG8_STAGE(PG8_SB(0, 1), b2 + hstepB, voffB); PG8_STAGE(PG8_SA(0, 0), a2, voffA);
            PG8_WAIT_V(8); PG8_WAIT_L(0); PG8_BAR; PG8_MMA(1, 0, At, B0); PG8_MMA(1, 1, At, B1); PG8_BAR; PG8_SCHED;
            PG8_LDB(B0, 1, 0); PG8_LDB(B1, 1, 1); PG8_SCHED; PG8_LDA(At, 1, 0); PG8_STAGE(PG8_SA(0, 1), a2 + hstepA, voffA);
            PG8_WAIT_V(8); PG8_WAIT_L(0); PG8_BAR; PG8_MMA(0, 0, At, B0); PG8_MMA(0, 1, At, B1); PG8_BAR; PG8_SCHED;
            PG8_LDA(At, 1, 1); PG8_STAGE(PG8_SB(1, 0), b3, voffB); PG8_STAGE(PG8_SB(1, 1), b3 + hstepB, voffB); PG8_STAGE(PG8_SA(1, 0), a3, voffA);
            PG8_WAIT_V(8); PG8_WAIT_L(0); PG8_BAR; PG8_MMA(1, 0, At, B0); PG8_MMA(1, 1, At, B1); PG8_BAR; PG8_SCHED;
            } else {
            PG8_LDB(B0, 0, 0); PG8_SCHED; PG8_LDA(At, 0, 0); PG8_STAGE(PG8_SA(1, 1), a1 + hstepA, voffA);
            PG8_WAIT_L(8); PG8_BAR; PG8_WAIT_L(0); PG8_MMA(0, 0, At, B0); PG8_BAR; PG8_SCHED;
            PG8_LDB(B1, 0, 1); PG8_STAGE(PG8_SB(0, 0), b2, voffB);
            PG8_BAR; PG8_WAIT_L(0); PG8_MMA(0, 1, At, B1); PG8_BAR;
            PG8_LDA(At, 0, 1); PG8_STAGE(PG8_SA(0, 0), a2, voffA);
            PG8_BAR; PG8_WAIT_L(0); PG8_MMA(1, 0, At, B0); PG8_BAR; PG8_SCHED;
            PG8_STAGE(PG8_SB(0, 1), b2 + hstepB, voffB);
            PG8_WAIT_V(6); PG8_BAR; PG8_MMA(1, 1, At, B1); PG8_BAR;
            PG8_LDB(B0, 1, 0); PG8_SCHED; PG8_LDA(At, 1, 0); PG8_STAGE(PG8_SA(0, 1), a2 + hstepA, voffA);
            PG8_WAIT_L(8); PG8_BAR; PG8_WAIT_L(0); PG8_MMA(0, 0, At, B0); PG8_BAR; PG8_SCHED;
            PG8_LDB(B1, 1, 1); PG8_STAGE(PG8_SB(1, 0), b3, voffB);
            PG8_BAR; PG8_WAIT_L(0); PG8_MMA(0, 1, At, B1); PG8_BAR;
            PG8_LDA(At, 1, 1); PG8_STAGE(PG8_SA(1, 0), a3, voffA);
            PG8_BAR; PG8_WAIT_L(0); PG8_MMA(1, 0, At, B0); PG8_BAR; PG8_SCHED;
            PG8_STAGE(PG8_SB(1, 1), b3 + hstepB, voffB);
            PG8_WAIT_V(6); PG8_BAR; PG8_MMA(1, 1, At, B1); PG8_BAR;
            }
        }
        if constexpr (ALIGN_EPI) { if (wr == 0) PG8_BAR; }
        if constexpr (!Epi::AFTER_DRAIN) { E(acc, cur, wr, wc, fr, fq); }
        if (!has_next) break;
#pragma unroll
        for (int a = 0; a < 2; ++a)
#pragma unroll
            for (int b = 0; b < 2; ++b)
#pragma unroll
                for (int m = 0; m < 4; ++m)
#pragma unroll
                    for (int n = 0; n < 2; ++n) acc[a][b][m][n] = (f32x4){0.f, 0.f, 0.f, 0.f};
        cur = nxt; cA = nA; cB = nB; ++ui;
        if constexpr (ALIGN_EPI) { if (wr == 1) PG8_BAR; }
    }
    PG8_WAIT_V(0);
    if constexpr (!ALIGN_EPI) { if (wr == 0) PG8_BAR; }
    PG8_BAR;
    if constexpr (Epi::AFTER_DRAIN) { E.fused(acc, cur, wr, wc, fr, fq, lds, wid, lane); }
#undef PG8_SA
#undef PG8_SB
#undef PG8_STAGE
#undef PG8_LDA
#undef PG8_LDB
#undef PG8_MMA
#undef PG8_WAIT_V
#undef PG8_WAIT_L
#undef PG8_BAR
#undef PG8_SCHED
}

typedef f32x4 Acc[2][2][4][2];
#define PACK8(v0, v1) (u32x4){cvt_pk_bf16((v0)[0], (v0)[1]), cvt_pk_bf16((v0)[2], (v0)[3]), cvt_pk_bf16((v1)[0], (v1)[1]), cvt_pk_bf16((v1)[2], (v1)[3])}

struct EpiGateUp {
    static constexpr bool PERM = true, AFTER_DRAIN = false;
    bf16_t* H; const float* ssq;
    __device__ __forceinline__ void operator()(const Acc& acc, const Unit& u, int wr, int wc, int fr, int fq) const {
        const int row0 = u.pm * BM + wr * 64 + fr, col0 = u.pn * 128 + wc * 32 + 8 * fq;
#pragma unroll
        for (int ai = 0; ai < 2; ++ai)
#pragma unroll
            for (int m = 0; m < 4; ++m) { const int r = row0 + ai * HALF + m * 16; const float rs = rstd_of(ssq[r], 1.0f / 2048.0f);
                f32x4 o[2];
#pragma unroll
                for (int n = 0; n < 2; ++n)
#pragma unroll
                    for (int i = 0; i < 4; ++i) { const float gt = acc[ai][0][m][n][i] * rs, up = acc[ai][1][m][n][i] * rs; o[n][i] = siluf_(gt) * up; }
                *(u32x4*)(H + (size_t)r * DFF + col0) = PACK8(o[0], o[1]); }
    }
};
struct EpiResid {
    static constexpr bool PERM = false, AFTER_DRAIN = false;
    const float* xsrc; float* xdst; bf16_t* xb; float* ssq_out; float alpha; int want_next;
    __device__ __forceinline__ void operator()(const Acc& acc, const Unit& u, int wr, int wc, int fr, int fq) const {
        const int row0 = u.pm * BM + wr * 64 + fr, col0 = u.pn * BM + wc * 32 + 4 * fq;
#pragma unroll
        for (int ai = 0; ai < 2; ++ai)
#pragma unroll
            for (int m = 0; m < 4; ++m) { const int r = row0 + ai * HALF + m * 16; const size_t off = (size_t)r * DM + col0; float s = 0.f;
#pragma unroll
                for (int bj = 0; bj < 2; ++bj)
#pragma unroll
                    for (int n = 0; n < 2; ++n) { const size_t o2 = off + bj * HALF + n * 16; const f32x4 xv = *(const f32x4*)(xsrc + o2); const f32x4 o = xv + acc[ai][bj][m][n] * alpha;
                        *(f32x4*)(xdst + o2) = o;
                        if (want_next) { s += (o[0] * o[0] + o[1] * o[1]) + (o[2] * o[2] + o[3] * o[3]); *(u32x2*)(xb + o2) = (u32x2){cvt_pk_bf16(o[0], o[1]), cvt_pk_bf16(o[2], o[3])}; } }
                if (want_next) { s += __shfl_xor(s, 16); s += __shfl_xor(s, 32); if (fq == 0) atomicAdd(ssq_out + r, s); } }
    }
};
struct EpiWin {
    static constexpr bool PERM = true, AFTER_DRAIN = false;
    const float* ssq; bf16_t* AGLU; bf16_t* CQ; bf16_t* CKV; bf16_t* KPE; float* ssq_cq; float* ssq_ckv;
    __device__ __forceinline__ void operator()(const Acc& acc, const Unit& u, int wr, int wc, int fr, int fq) const {
        const int row0 = u.pm * BM + wr * 64 + fr, cw = wc * 32 + 8 * fq, pn = u.pn;
#pragma unroll
        for (int ai = 0; ai < 2; ++ai)
#pragma unroll
            for (int m = 0; m < 4; ++m) { const int r = row0 + ai * HALF + m * 16; const float rs = rstd_of(ssq[r], 1.0f / 2048.0f);
                if (pn < 8) {
                    f32x4 o[2];
#pragma unroll
                    for (int n = 0; n < 2; ++n)
#pragma unroll
                        for (int i = 0; i < 4; ++i) o[n][i] = (acc[ai][0][m][n][i] * rs) * sigmoidf_(acc[ai][1][m][n][i] * rs);
                    *(u32x4*)(AGLU + (size_t)r * 1024 + pn * 128 + cw) = PACK8(o[0], o[1]);
                } else if (pn < 12) {
                    float s = 0.f;
#pragma unroll
                    for (int bj = 0; bj < 2; ++bj) { const f32x4 v0 = acc[ai][bj][m][0] * rs, v1 = acc[ai][bj][m][1] * rs;
                        s += (v0[0] * v0[0] + v0[1] * v0[1]) + (v0[2] * v0[2] + v0[3] * v0[3]) + (v1[0] * v1[0] + v1[1] * v1[1]) + (v1[2] * v1[2] + v1[3] * v1[3]);
                        if (pn < 11) *(u32x4*)(CQ + (size_t)r * 768 + (pn - 8) * 256 + bj * HALF + cw) = PACK8(v0, v1);
                        else *(u32x4*)(CKV + (size_t)r * 256 + bj * HALF + cw) = PACK8(v0, v1); }
                    s += __shfl_xor(s, 16); s += __shfl_xor(s, 32);
                    if (fq == 0) atomicAdd((pn < 11 ? ssq_cq : ssq_ckv) + r, s);
                } else {
                    if (wc < 2) { const f32x4 v0 = acc[ai][0][m][0] * rs, v1 = acc[ai][0][m][1] * rs; *(u32x4*)(KPE + (size_t)r * 64 + cw) = PACK8(v0, v1); }
                } }
    }
};
struct EpiPlain {
    static constexpr bool PERM = true, AFTER_DRAIN = false;
    bf16_t* O; int ldc; const float* ssq; float inv_n;
    __device__ __forceinline__ void operator()(const Acc& acc, const Unit& u, int wr, int wc, int fr, int fq) const {
        const int row0 = u.pm * BM + wr * 64 + fr, col0 = u.pn * BM + wc * 32 + 8 * fq;
#pragma unroll
        for (int ai = 0; ai < 2; ++ai)
#pragma unroll
            for (int m = 0; m < 4; ++m) { const int r = row0 + ai * HALF + m * 16; const float rs = ssq ? rstd_of(ssq[r], inv_n) : 1.0f;
#pragma unroll
                for (int bj = 0; bj < 2; ++bj) { const f32x4 v0 = acc[ai][bj][m][0] * rs, v1 = acc[ai][bj][m][1] * rs; *(u32x4*)(O + (size_t)r * ldc + col0 + bj * HALF) = PACK8(v0, v1); } }
    }
};
struct EpiCq {
    static constexpr bool PERM = true, AFTER_DRAIN = false;
    bf16_t* QC; const float* ssq; float* ssq_qc;
    __device__ __forceinline__ void operator()(const Acc& acc, const Unit& u, int wr, int wc, int fr, int fq) const {
        const int row0 = u.pm * BM + wr * 64 + fr, col0 = u.pn * BM + wc * 32 + 8 * fq, head = u.pn >> 1;
#pragma unroll
        for (int ai = 0; ai < 2; ++ai)
#pragma unroll
            for (int m = 0; m < 4; ++m) { const int r = row0 + ai * HALF + m * 16; const float rs = rstd_of(ssq[r], 1.0f / 2048.0f); float s = 0.f;
#pragma unroll
                for (int bj = 0; bj < 2; ++bj) { const f32x4 v0 = acc[ai][bj][m][0] * rs, v1 = acc[ai][bj][m][1] * rs;
                    s += (v0[0] * v0[0] + v0[1] * v0[1]) + (v0[2] * v0[2] + v0[3] * v0[3]) + (v1[0] * v1[0] + v1[1] * v1[1]) + (v1[2] * v1[2] + v1[3] * v1[3]);
                    *(u32x4*)(QC + (size_t)r * DM + col0 + bj * HALF) = PACK8(v0, v1); }
                s += __shfl_xor(s, 16); s += __shfl_xor(s, 32);
                if (fq == 0) atomicAdd(ssq_qc + r * 4 + head, s); }
    }
};
struct EpiMemKV {
    static constexpr bool PERM = true, AFTER_DRAIN = false;
    const float* ssq_mem; const float* gq; const float* gk; bf16_t* KC; bf16_t* VT; float* ssq_kc;
    __device__ __forceinline__ void operator()(const Acc& acc, const Unit& u, int wr, int wc, int fr, int fq) const {
        const int row0 = u.pm * BM + wr * 64 + fr, pn = u.pn;
#pragma unroll
        for (int ai = 0; ai < 2; ++ai)
#pragma unroll
            for (int m = 0; m < 4; ++m) { const int r = row0 + ai * HALF + m * 16; const float rs = rstd_of(ssq_mem[r], 1.0f / 2048.0f);
                if (pn < 8) { float s = 0.f;
#pragma unroll
                    for (int bj = 0; bj < 2; ++bj) { const int col = pn * BM + bj * HALF + wc * 32 + 8 * fq, d = col & 511; f32x4 v[2];
#pragma unroll
                        for (int n = 0; n < 2; ++n) { v[n] = acc[ai][bj][m][n] * rs; s += (v[n][0] * v[n][0] + v[n][1] * v[n][1]) + (v[n][2] * v[n][2] + v[n][3] * v[n][3]);
                            const f32x4 a = *(const f32x4*)(gq + d + 4 * n), b = *(const f32x4*)(gk + d + 4 * n); v[n] = v[n] * a * b; }
                        *(u32x4*)(KC + (size_t)r * DM + col) = PACK8(v[0], v[1]); }
                    s += __shfl_xor(s, 16); s += __shfl_xor(s, 32);
                    if (fq == 0) atomicAdd(ssq_kc + r * 4 + (pn >> 1), s);
                } else {
                    const int b = r >> 8, mm = r & 255;
#pragma unroll
                    for (int bj = 0; bj < 2; ++bj)
#pragma unroll
                        for (int n = 0; n < 2; ++n)
#pragma unroll
                            for (int i = 0; i < 4; ++i) { const int col = (pn - 8) * BM + bj * HALF + wc * 32 + 8 * fq + 4 * n + i, h = col >> 9, d = col & 511;
                                VT[((size_t)((b * 4 + h) * 512 + d)) * 256 + mm] = (bf16_t)(cvt_pk_bf16(acc[ai][bj][m][n][i] * rs, 0.f) & 0xffffu); }
                } }
    }
};
struct EpiSoftmax {
    static constexpr bool PERM = true, AFTER_DRAIN = true;
    bf16_t* P; const float* ssq_qc; const float* ssq_kc;
    __device__ __forceinline__ void fused(Acc& acc, const Unit& u, int wr, int wc, int fr, int fq, LAS unsigned char* lds, int wid, int lane) const {
        LAS float* X = (LAS float*)lds; LAS float* Y = X + 1024;
        const int h = u.pn, b = u.pm >> 5;
        f32x4 rk[2][2];
#pragma unroll
        for (int bj = 0; bj < 2; ++bj)
#pragma unroll
            for (int n = 0; n < 2; ++n)
#pragma unroll
                for (int i = 0; i < 4; ++i) { const int mm = bj * HALF + wc * 32 + 8 * fq + 4 * n + i; rk[bj][n][i] = rstd_of(ssq_kc[(b * 256 + mm) * 4 + h], 1.0f / 512.0f) * XSCALE; }
#pragma unroll
        for (int ai = 0; ai < 2; ++ai)
#pragma unroll
            for (int m = 0; m < 4; ++m) { const int rl = ai * HALF + wr * 64 + m * 16 + fr, r = u.pm * BM + rl; const float rq = rstd_of(ssq_qc[r * 4 + h], 1.0f / 512.0f); float mx = -3.0e38f;
#pragma unroll
                for (int bj = 0; bj < 2; ++bj)
#pragma unroll
                    for (int n = 0; n < 2; ++n) { const f32x4 v = acc[ai][bj][m][n] * rk[bj][n] * rq; acc[ai][bj][m][n] = v; mx = fmaxf(fmaxf(mx, fmaxf(v[0], v[1])), fmaxf(v[2], v[3])); }
                mx = fmaxf(mx, __shfl_xor(mx, 16)); mx = fmaxf(mx, __shfl_xor(mx, 32));
                if (fq == 0) X[rl * 4 + wc] = mx; }
        LDS_WAIT(); __builtin_amdgcn_s_barrier(); asm volatile("" ::: "memory");
#pragma unroll
        for (int ai = 0; ai < 2; ++ai)
#pragma unroll
            for (int m = 0; m < 4; ++m) { const int rl = ai * HALF + wr * 64 + m * 16 + fr; const float mx = fmaxf(fmaxf(X[rl * 4 + 0], X[rl * 4 + 1]), fmaxf(X[rl * 4 + 2], X[rl * 4 + 3])); float s = 0.f;
#pragma unroll
                for (int bj = 0; bj < 2; ++bj)
#pragma unroll
                    for (int n = 0; n < 2; ++n) { f32x4 v = acc[ai][bj][m][n];
#pragma unroll
                        for (int i = 0; i < 4; ++i) { v[i] = __builtin_amdgcn_exp2f(v[i] - mx); s += v[i]; }
                        acc[ai][bj][m][n] = v; }
                s += __shfl_xor(s, 16); s += __shfl_xor(s, 32);
                if (fq == 0) Y[rl * 4 + wc] = s; }
        LDS_WAIT(); __builtin_amdgcn_s_barrier(); asm volatile("" ::: "memory");
#pragma unroll
        for (int ai = 0; ai < 2; ++ai)
#pragma unroll
            for (int m = 0; m < 4; ++m) { const int rl = ai * HALF + wr * 64 + m * 16 + fr, r = u.pm * BM + rl; const float inv = 1.0f / ((Y[rl * 4 + 0] + Y[rl * 4 + 1]) + (Y[rl * 4 + 2] + Y[rl * 4 + 3]));
#pragma unroll
                for (int bj = 0; bj < 2; ++bj) { const f32x4 v0 = acc[ai][bj][m][0] * inv, v1 = acc[ai][bj][m][1] * inv;
                    *(u32x4*)(P + (size_t)r * 1024 + h * 256 + bj * HALF + wc * 32 + 8 * fq) = PACK8(v0, v1); } }
        LDS_WAIT(); __builtin_amdgcn_s_barrier(); asm volatile("" ::: "memory");
    }
};
}

namespace mla {
constexpr int NW = 8, QBLK = 32, KVBLK = 64, LDQ = 1536, LDK = 1536, LDV = 2048, LDO = 2048;
constexpr int SHM_V = 64 * 128 * 2, SHM_K = 64 * 192 * 2, SHM_ATTN = 2 * SHM_V + 2 * SHM_K + NW * 64 * 4;
constexpr float THRL = 8.0f;
#define KSWZ(row, colB) ((row) * 384 + ((colB) ^ ((((row) >> 1) & 7) << 4)))
#define SBAR() __builtin_amdgcn_sched_barrier(0)
__device__ __forceinline__ int crow(int r, int hi) { return (r & 3) + 8 * (r >> 2) + 4 * hi; }
__device__ __forceinline__ int v_st(int k, int c) { const int kk = (k & ~0xC) | ((k & 4) << 1) | ((k & 8) >> 1); return ((kk >> 3) * 4 + (c >> 5)) * 512 + ((kk & 7) * 32 + (c & 31)) * 2; }
__device__ __forceinline__ int v_rd_base(int lane) { return ((lane & 3) << 3) | (((lane >> 2) & 3) << 6) | (((lane >> 4) & 1) << 5) | (((lane >> 5) & 1) << 8); }
constexpr int v_rd_off(int d0, int ks, int half) { return d0 * 512 + ks * 4096 + half * 2048; }
template <int OFF> __device__ __forceinline__ s16x4 tr_read(int vb) {
    s16x4 r; asm volatile("ds_read_b64_tr_b16 %0, %1 offset:%2" : "=&v"(r) : "v"(vb), "i"(OFF) : "memory"); return r;
}
template <int D0> __device__ __forceinline__ void pv_one(f32x16& od, int vb, bf16x8 pa0, bf16x8 pa1, bf16x8 pa2, bf16x8 pa3) {
    const s16x4 l0 = tr_read<v_rd_off(D0, 0, 0)>(vb), h0 = tr_read<v_rd_off(D0, 0, 1)>(vb), l1 = tr_read<v_rd_off(D0, 1, 0)>(vb), h1 = tr_read<v_rd_off(D0, 1, 1)>(vb);
    const s16x4 l2 = tr_read<v_rd_off(D0, 2, 0)>(vb), h2 = tr_read<v_rd_off(D0, 2, 1)>(vb), l3 = tr_read<v_rd_off(D0, 3, 0)>(vb), h3 = tr_read<v_rd_off(D0, 3, 1)>(vb);
    asm volatile("s_waitcnt lgkmcnt(0)" ::: "memory"); SBAR();
#define PK(L, H) (bf16x8){L[0], L[1], L[2], L[3], H[0], H[1], H[2], H[3]}
    od = __builtin_amdgcn_mfma_f32_32x32x16_bf16(pa0, PK(l0, h0), od, 0, 0, 0);
    od = __builtin_amdgcn_mfma_f32_32x32x16_bf16(pa1, PK(l1, h1), od, 0, 0, 0);
    od = __builtin_amdgcn_mfma_f32_32x32x16_bf16(pa2, PK(l2, h2), od, 0, 0, 0);
    od = __builtin_amdgcn_mfma_f32_32x32x16_bf16(pa3, PK(l3, h3), od, 0, 0, 0);
#undef PK
}
__device__ __forceinline__ void attn_unit(int b, int h, int qb, const bf16_t* __restrict__ QF, const bf16_t* __restrict__ KF, const bf16_t* __restrict__ KVR, bf16_t* __restrict__ MIX, char* lds) {
    int tid_ = threadIdx.x; asm volatile("" : "+v"(tid_));
    const int tid = tid_, wid = tid >> 6, lane = tid & 63, r32 = lane & 31, hi = lane >> 5;
    char* V_lds = lds; char* K_lds = lds + 2 * SHM_V;
    float* ws = (float*)(lds + 2 * SHM_V + 2 * SHM_K) + wid * 64; float* li_l = ws; float* al_l = ws + 32;
    const long rowbase = (long)b * SEQ; const int q0 = qb * 256;
    float m_reg = -1e30f, l_reg = 0.f; f32x16 o[4] = {}; bf16x8 qr[12];
    const bf16_t* Qw = QF + (rowbase + q0 + wid * QBLK + r32) * LDQ + h * 192 + hi * 8;
#pragma unroll
    for (int d0 = 0; d0 < 12; ++d0) qr[d0] = *reinterpret_cast<const bf16x8*>(Qw + d0 * 16);
    const bf16_t* Kh = KF + rowbase * LDK + h * 192; const bf16_t* Vh = KVR + rowbase * LDV + h * 256 + 128;
    const int sr = tid >> 4, sc = (tid & 15) * 8, vst0 = v_st(sr, sc), vst1 = v_st(32 + sr, sc);
    int krow[3], kcol[3], kst[3];
#pragma unroll
    for (int i = 0; i < 3; ++i) { const int c = tid + 512 * i; krow[i] = c / 24; kcol[i] = (c % 24) * 8; kst[i] = KSWZ(krow[i], kcol[i] * 2); }
    const int vb0 = (int)(uintptr_t)V_lds + v_rd_base(lane);
    bf16x8 sv0, sv1, sk0, sk1, sk2;
#define SLOAD(k0) do { sv0 = *reinterpret_cast<const bf16x8*>(&Vh[(long)((k0) + sr) * LDV + sc]); sv1 = *reinterpret_cast<const bf16x8*>(&Vh[(long)((k0) + 32 + sr) * LDV + sc]); \
    sk0 = *reinterpret_cast<const bf16x8*>(&Kh[(long)((k0) + krow[0]) * LDK + kcol[0]]); sk1 = *reinterpret_cast<const bf16x8*>(&Kh[(long)((k0) + krow[1]) * LDK + kcol[1]]); \
    sk2 = *reinterpret_cast<const bf16x8*>(&Kh[(long)((k0) + krow[2]) * LDK + kcol[2]]); } while (0)
#define SWRITE(bb) do { *(bf16x8*)(V_lds + (bb) * SHM_V + vst0) = sv0; *(bf16x8*)(V_lds + (bb) * SHM_V + vst1) = sv1; \
    *(bf16x8*)(K_lds + (bb) * SHM_K + kst[0]) = sk0; *(bf16x8*)(K_lds + (bb) * SHM_K + kst[1]) = sk1; *(bf16x8*)(K_lds + (bb) * SHM_K + kst[2]) = sk2; } while (0)
    const int NT = 4 * qb + 4, tmax = 4 * qb + (wid >> 1);
    SLOAD(0); VM_WAIT(); SWRITE(0); __syncthreads();
    for (int j = 0; j < NT; ++j) {
        const int bb = j & 1;
        if (j + 1 < NT) SLOAD((j + 1) * KVBLK);
        if (j <= tmax) {
            f32x16 p0 = {}, p1 = {};
            const char* Ks = K_lds + bb * SHM_K;
#pragma unroll
            for (int d0 = 0; d0 < 12; ++d0) { const int cb = (d0 * 16 + hi * 8) * 2;
                const bf16x8 b0 = *reinterpret_cast<const bf16x8*>(Ks + KSWZ(r32, cb));
                const bf16x8 b1 = *reinterpret_cast<const bf16x8*>(Ks + KSWZ(32 + r32, cb));
                p0 = __builtin_amdgcn_mfma_f32_32x32x16_bf16(b0, qr[d0], p0, 0, 0, 0);
                p1 = __builtin_amdgcn_mfma_f32_32x32x16_bf16(b1, qr[d0], p1, 0, 0, 0); }
            float pmax = p0[0];
#pragma unroll
            for (int r = 1; r < 16; ++r) pmax = fmaxf(pmax, p0[r]);
#pragma unroll
            for (int r = 0; r < 16; ++r) pmax = fmaxf(pmax, p1[r]);
            { auto rr = __builtin_amdgcn_permlane32_swap(__float_as_uint(pmax), __float_as_uint(pmax), false, false);
              pmax = fmaxf(__uint_as_float(rr[0]), __uint_as_float(rr[1])); }
            if (!__all(pmax - m_reg <= THRL)) {
                const float mn = fmaxf(m_reg, pmax); const float alpha = __builtin_amdgcn_exp2f(m_reg - mn); m_reg = mn; l_reg *= alpha;
                if (hi == 0) al_l[r32] = alpha;
                LDS_WAIT();
#pragma unroll
                for (int d = 0; d < 4; ++d)
#pragma unroll
                    for (int r = 0; r < 16; ++r) o[d][r] *= al_l[crow(r, hi)];
            }
            float ps = 0.f;
#pragma unroll
            for (int r = 0; r < 16; ++r) { p0[r] = __builtin_amdgcn_exp2f(p0[r] - m_reg); ps += p0[r]; }
#pragma unroll
            for (int r = 0; r < 16; ++r) { p1[r] = __builtin_amdgcn_exp2f(p1[r] - m_reg); ps += p1[r]; }
            { auto rr = __builtin_amdgcn_permlane32_swap(__float_as_uint(ps), __float_as_uint(ps), false, false);
              ps = __uint_as_float(rr[0]) + __uint_as_float(rr[1]); }
            l_reg += ps;
            bf16x8 pa0, pa1, pa2, pa3;
#define PK4(P, BASE, OUT) do { unsigned a0 = cvt_pk_bf16(P[BASE + 0], P[BASE + 1]), a1 = cvt_pk_bf16(P[BASE + 2], P[BASE + 3]);   \
    unsigned b0 = cvt_pk_bf16(P[BASE + 4], P[BASE + 5]), b1 = cvt_pk_bf16(P[BASE + 6], P[BASE + 7]);                              \
    auto r0 = __builtin_amdgcn_permlane32_swap(a0, b0, false, false); auto r1 = __builtin_amdgcn_permlane32_swap(a1, b1, false, false); \
    u32x4 w = {r0[0], r1[0], r0[1], r1[1]}; OUT = *reinterpret_cast<bf16x8*>(&w); } while (0)
            PK4(p0, 0, pa0); PK4(p0, 8, pa1); PK4(p1, 0, pa2); PK4(p1, 8, pa3);
#undef PK4
            const int vb = vb0 + bb * SHM_V;
            pv_one<0>(o[0], vb, pa0, pa1, pa2, pa3); pv_one<1>(o[1], vb, pa0, pa1, pa2, pa3); pv_one<2>(o[2], vb, pa0, pa1, pa2, pa3); pv_one<3>(o[3], vb, pa0, pa1, pa2, pa3);
        }
        if (j + 1 < NT) { VM_WAIT(); SWRITE(bb ^ 1); }
        __syncthreads();
    }
    if (hi == 0) li_l[r32] = l_reg;
    LDS_WAIT();
    float rli[16];
#pragma unroll
    for (int r = 0; r < 16; ++r) rli[r] = __builtin_amdgcn_rcpf(li_l[crow(r, hi)]);
    bf16_t* Ow = MIX + (rowbase + q0 + wid * QBLK) * LDO + 1024 + h * 128;
#pragma unroll
    for (int r = 0; r < 16; ++r) { const int orow = crow(r, hi);
#pragma unroll
        for (int d0 = 0; d0 < 4; ++d0) Ow[(long)orow * LDO + d0 * 32 + r32] = (bf16_t)(cvt_pk_bf16(o[d0][r] * rli[r], 0.f) & 0xffffu); }
    __syncthreads();
#undef SLOAD
#undef SWRITE
}
#undef SBAR
}

struct Args { const void* in[32]; float* out; unsigned char* ws; };

__device__ const float INV_FREQ[32] = {
    1.000000000e+00f, 7.498942018e-01f, 5.623413324e-01f, 4.216965139e-01f, 3.162277639e-01f, 2.371373922e-01f, 1.778279394e-01f, 1.333521456e-01f,
    1.000000015e-01f, 7.498941571e-02f, 5.623412877e-02f, 4.216964915e-02f, 3.162277862e-02f, 2.371373586e-02f, 1.778279431e-02f, 1.333521493e-02f,
    9.999999776e-03f, 7.498942316e-03f, 5.623413250e-03f, 4.216964822e-03f, 3.162277862e-03f, 2.371373819e-03f, 1.778279431e-03f, 1.333521446e-03f,
    1.000000047e-03f, 7.498941850e-04f, 5.623413017e-04f, 4.216965463e-04f, 3.162277862e-04f, 2.371373848e-04f, 1.778279402e-04f, 1.333521504e-04f};

__device__ __forceinline__ void transpose_job(const float* W, int ldw, int K, int ncols, const float* gain, bf16_t* WT, int mode, int off,
                                              LAS float* scr, int& base, int gw, int NGW, int lane) {
    const int nblk = ncols / 32, nitems = (K / 64) * nblk;
    const int first = (gw + NGW - (base % NGW)) % NGW;
    for (int it = first; it < nitems; it += NGW) {
        const int kb = it / nblk, nb = it % nblk, k0 = 64 * kb, n0 = 32 * nb;
#pragma unroll 8
        for (int i = 0; i < 32; ++i) { const int kk = 2 * i + (lane >> 5); float v = W[(size_t)(k0 + kk) * ldw + n0 + (lane & 31)]; if (gain) v *= gain[k0 + kk]; scr[kk * 33 + (lane & 31)] = v; }
        LDS_WAIT(); asm volatile("" ::: "memory");
        const int c = lane & 7;
#pragma unroll
        for (int j = 0; j < 4; ++j) { const int n = (lane >> 3) + 8 * j; const LAS float* s = scr + (8 * c) * 33 + n;
            u32x4 o; o.x = cvt_pk_bf16(s[0 * 33], s[1 * 33]); o.y = cvt_pk_bf16(s[2 * 33], s[3 * 33]); o.z = cvt_pk_bf16(s[4 * 33], s[5 * 33]); o.w = cvt_pk_bf16(s[6 * 33], s[7 * 33]);
            const int nn = n0 + n; const int drow = (mode == 0) ? (nn + off) : (((nn >> 7) << 8) + (nn & 127) + off);
            *(u32x4*)(WT + (size_t)drow * K + k0 + 8 * c) = o; }
        LDS_WAIT(); asm volatile("" ::: "memory");
    }
    base += nitems;
}

__global__ void __launch_bounds__(512, 2) fwd_megakernel(Args a) {
    extern __shared__ __attribute__((aligned(16))) unsigned char lds_raw[];
    cg::grid_group grid = cg::this_grid();
    LAS unsigned char* lds = (LAS unsigned char*)lds_raw;
    int tid = threadIdx.x;
#define lane (tid & 63)
#define wave (__builtin_amdgcn_readfirstlane(tid >> 6))
    const int G = gridDim.x, bx = blockIdx.x;
    const int vcu = (G % 8 == 0) ? (bx % 8) * (G / 8) + bx / 8 : bx;
    const int NGW = G * 8;
#define gw (vcu * 8 + wave)
    unsigned char* ws = a.ws;
    const float* x_in = (const float*)a.in[0];
    float* out = a.out;
#define PHASE_FENCE() do { asm volatile("" : "+s"(ws)); asm volatile("" : "+s"(out)); asm volatile("" : "+v"(tid)); } while (0)
#define GAS __attribute__((address_space(1)))
#define WSG ((GAS unsigned char*)ws)
#define ssq ((float*)(WSG + WS_SSQ))
#define PAR ((const float*)(WSG + WS_PAR))
#define XB ((bf16_t*)(WSG + WS_XB))
#define HB ((bf16_t*)(WSG + WS_H))
#define KVR ((bf16_t*)(WSG + WS_KVR))
#define MIX ((bf16_t*)(WSG + WS_MIX))
#define MEMB ((bf16_t*)(WSG + WS_MEMB))
#define AGLU ((bf16_t*)(WSG + WS_H + H_AGLU))
#define CQ ((bf16_t*)(WSG + WS_H + H_CQ))
#define CKV ((bf16_t*)(WSG + WS_H + H_CKV))
#define KPE ((bf16_t*)(WSG + WS_H + H_KPE))
#define QF ((bf16_t*)(WSG + WS_H + H_QF))
#define KF ((bf16_t*)(WSG + WS_H + H_KF))
#define QC ((bf16_t*)(WSG + WS_H + H_QC))
#define PC ((bf16_t*)(WSG + WS_H + H_PC))
#define OC ((bf16_t*)(WSG + WS_H + H_OC))
#define WPTR(l, o) ((bf16_t*)(WSG + WS_W + (size_t)(l) * LW + (o)))
#define PARL(l, o) (PAR + PAR_L0 + (l) * PAR_LS + (o))

    {
        for (int i = bx * 512 + tid; i < ZERO_COUNT; i += G * 512) ssq[i] = 0.f;
        { float* par = (float*)(WSG + WS_PAR); const int gt = bx * 512 + tid, GT = G * 512;
          for (int i = gt; i < M; i += GT) ((int*)par)[PAR_POS + i] = ((const int*)a.in[2])[i];
          for (int i = gt; i < 2 * 31744; i += GT) { const int l = i / 31744, j = i % 31744; par[PAR_L0 + l * PAR_LS + PAR_CONVW + j] = ((const float*)a.in[9])[i]; }
          for (int i = gt; i < 2 * 1024; i += GT) { const int l = i >> 10, j = i & 1023; float* pl = par + PAR_L0 + l * PAR_LS;
              pl[PAR_CONVB + j] = ((const float*)a.in[10])[i]; pl[PAR_LNG + j] = ((const float*)a.in[11])[i]; pl[PAR_LNB + j] = ((const float*)a.in[12])[i];
              if (j < 512) { pl[PAR_CQN + j] = ((const float*)a.in[25])[l * 512 + j]; pl[PAR_CKN + j] = ((const float*)a.in[26])[l * 512 + j]; }
              if (j < 192) { pl[PAR_QN + j] = ((const float*)a.in[17])[l * 192 + j]; pl[PAR_KN + j] = ((const float*)a.in[18])[l * 192 + j]; } } }
        for (int l = 0; l < 2; ++l) { u32x4* p = (u32x4*)(WPTR(l, W_IN) + (size_t)NIN * DM); const int n16 = (NINP - NIN) * DM / 8;
            for (int i = bx * 512 + tid; i < n16; i += G * 512) p[i] = (u32x4){0u, 0u, 0u, 0u}; }
        for (int row = gw; row < M + MMEM; row += NGW) {
            const bool is_x = row < M; const int rr = is_x ? row : row - M;
            const float* src = (is_x ? x_in : (const float*)a.in[1]) + (size_t)rr * DM; bf16_t* dst = (is_x ? XB : MEMB) + (size_t)rr * DM;
            float s = 0.f;
#pragma unroll
            for (int j = 0; j < 8; ++j) { const f32x4 v = *(const f32x4*)(src + 256 * j + 4 * lane); s += (v[0] * v[0] + v[1] * v[1]) + (v[2] * v[2] + v[3] * v[3]);
                *(u32x2*)(dst + 256 * j + 4 * lane) = (u32x2){cvt_pk_bf16(v[0], v[1]), cvt_pk_bf16(v[2], v[3])}; }
            s = wave_sum(s);
            if (lane == 0) ssq[(is_x ? NZ_X0 : NZ_MEM) + rr] = s;
        }
        LAS float* scr = (LAS float*)(lds + wave * 16384);
        int base = 0;
#pragma unroll 1
        for (int jb = 0; jb < 32; ++jb) {
            const int l = jb >> 4, j = jb & 15;
            const float* Wb = nullptr; const float* gb = nullptr; int ldw = DM, Kk = DM, nc = DM, mode = 0, off = 0, c0 = 0; size_t wo = 0, lstride = (size_t)DM * DM;
            switch (j) {
                case 0:  Wb = (const float*)a.in[4];  gb = (const float*)a.in[3];  ldw = DFF; Kk = DM;  nc = DFF;  mode = 1; off = 0;    wo = W_GU1; lstride = (size_t)DM * DFF; break;
                case 1:  Wb = (const float*)a.in[5];  gb = (const float*)a.in[3];  ldw = DFF; Kk = DM;  nc = DFF;  mode = 1; off = 128;  wo = W_GU1; lstride = (size_t)DM * DFF; break;
                case 2:  Wb = (const float*)a.in[6];  gb = nullptr; ldw = DM;  Kk = DFF; nc = DM;   mode = 0; off = 0;    wo = W_D1;  lstride = (size_t)DM * DFF; break;
                case 3:  Wb = (const float*)a.in[8];  gb = (const float*)a.in[7];  ldw = NIN; Kk = DM;  nc = 1024; mode = 1; off = 0;    wo = W_IN;  lstride = (size_t)DM * NIN; c0 = 0; break;
                case 4:  Wb = (const float*)a.in[8];  gb = (const float*)a.in[7];  ldw = NIN; Kk = DM;  nc = 1024; mode = 1; off = 128;  wo = W_IN;  lstride = (size_t)DM * NIN; c0 = 1024; break;
                case 5:  Wb = (const float*)a.in[8];  gb = (const float*)a.in[7];  ldw = NIN; Kk = DM;  nc = NIN - 2048; mode = 0; off = 2048; wo = W_IN; lstride = (size_t)DM * NIN; c0 = 2048; break;
                case 6:  Wb = (const float*)a.in[14]; gb = (const float*)a.in[13]; ldw = 1536; Kk = 768; nc = 1536; mode = 0; off = 0;   wo = W_QB;  lstride = (size_t)768 * 1536; break;
                case 7:  Wb = (const float*)a.in[16]; gb = (const float*)a.in[15]; ldw = 2048; Kk = 256; nc = 2048; mode = 0; off = 0;   wo = W_KVB; lstride = (size_t)256 * 2048; break;
                case 8:  Wb = (const float*)a.in[19]; gb = nullptr; wo = W_OUT; break;
                case 9:  Wb = (const float*)a.in[22]; gb = (const float*)a.in[20]; wo = W_CQ; break;
                case 10: Wb = (const float*)a.in[23]; gb = (const float*)a.in[21]; wo = W_CKV; break;
                case 11: Wb = (const float*)a.in[24]; gb = (const float*)a.in[21]; wo = W_CKV; off = 2048; break;
                case 12: Wb = (const float*)a.in[27]; gb = nullptr; wo = W_CO; break;
                case 13: Wb = (const float*)a.in[29]; gb = (const float*)a.in[28]; ldw = DFF; Kk = DM;  nc = DFF;  mode = 1; off = 0;    wo = W_GU2; lstride = (size_t)DM * DFF; break;
                case 14: Wb = (const float*)a.in[30]; gb = (const float*)a.in[28]; ldw = DFF; Kk = DM;  nc = DFF;  mode = 1; off = 128;  wo = W_GU2; lstride = (size_t)DM * DFF; break;
                default: Wb = (const float*)a.in[31]; gb = nullptr; ldw = DM;  Kk = DFF; nc = DM;   mode = 0; off = 0;    wo = W_D2;  lstride = (size_t)DM * DFF; break;
            }
            const float* Wp = Wb + (size_t)l * lstride + c0;
            const float* gp = gb ? gb + (size_t)l * Kk : nullptr;
            transpose_job(Wp, ldw, Kk, nc, gp, WPTR(l, wo), mode, off, scr, base, gw, NGW, lane);
        }
    }
    grid.sync(); PHASE_FENCE();

#pragma unroll 1
    for (int l = 0; l < 2; ++l) {
        pg8::Gemm g{MEMB, WPTR(l, W_CKV), DM, DM, DM, 0}; pg8::Order S; S.init(MMEM / 256, 4096 / 256, G, bx);
        pg8::EpiMemKV E{ssq + NZ_MEM, PARL(l, PAR_CQN), PARL(l, PAR_CKN), (bf16_t*)(WSG + WS_KC) + (size_t)l * MMEM * DM, (bf16_t*)(WSG + WS_VT) + (size_t)l * MMEM * DM, ssq + Z_KC + l * 2048};
        pg8::gemm_phase<pg8::EpiMemKV, pg8::Order, true, true>(lds, g, S, E);
    }

#pragma unroll 1
    for (int l = 0; l < 2; ++l) {
        {
            pg8::Gemm g{XB, WPTR(l, W_GU1), DM, DM, DM, 0}; pg8::Order S; S.init(M / 256, 2 * DFF / 256, G, bx);
            pg8::EpiGateUp E{HB, ssq + ssqx(4 * l + 0)};
            pg8::gemm_phase<pg8::EpiGateUp, pg8::Order, true, true>(lds, g, S, E);
        }
        grid.sync(); PHASE_FENCE();
        {
            pg8::Gemm g{HB, WPTR(l, W_D1), DFF, DFF, DFF, 0}; pg8::Order S; S.init(M / 256, DM / 256, G, bx);
            pg8::EpiResid E{l == 0 ? (const float*)(const GAS float*)x_in : (const float*)(GAS float*)out, (float*)(GAS float*)out, XB, ssq + ssqx(4 * l + 1), 0.5f, 1};
            pg8::gemm_phase<pg8::EpiResid, pg8::Order, true, true>(lds, g, S, E);
        }
        grid.sync(); PHASE_FENCE();
        {
            pg8::Gemm g{XB, WPTR(l, W_IN), DM, DM, DM, 0}; pg8::Order S; S.init(M / 256, NINP / 256, G, bx);
            pg8::EpiWin E{ssq + ssqx(4 * l + 1), AGLU, CQ, CKV, KPE, ssq + Z_CQ + l * M, ssq + Z_CKV + l * M};
            pg8::gemm_phase<pg8::EpiWin, pg8::Order, true, true>(lds, g, S, E);
        }
        grid.sync(); PHASE_FENCE();
#ifndef NO_CONV
        {
            const float* cw = PARL(l, PAR_CONVW); const float* cb = PARL(l, PAR_CONVB); const float* lg = PARL(l, PAR_LNG); const float* lb = PARL(l, PAR_LNB);
            const int c0 = 2 * tid;
            LAS unsigned* abuf = (LAS unsigned*)lds;
            LAS float* red = (LAS float*)(lds + 62 * 2048);
            float w0[31], w1[31];
#pragma unroll
            for (int k = 0; k < 31; ++k) { w0[k] = cw[k * 1024 + c0]; w1[k] = cw[k * 1024 + c0 + 1]; }
            const float b0 = cb[c0], b1 = cb[c0 + 1], g0 = lg[c0], g1 = lg[c0 + 1], e0 = lb[c0], e1 = lb[c0 + 1];
            for (int tile = bx; tile < M / 32; tile += G) {
                const int t0 = tile * 32, tl0 = t0 % SEQ;
                __syncthreads();
                for (int idx = tid; idx < 62 * 128; idx += 512) { const int rr = idx >> 7, cc = idx & 127; const bool valid = (tl0 - 30 + rr) >= 0;
                    u32x4 v = (u32x4){0u, 0u, 0u, 0u}; if (valid) v = *(const u32x4*)(AGLU + (size_t)(t0 - 30 + rr) * 1024 + cc * 8);
                    *(LAS u32x4*)(lds + rr * 2048 + cc * 16) = v; }
                __syncthreads();
#pragma unroll 1
                for (int half = 0; half < 2; ++half) {
                    float y0[16], y1[16];
#pragma unroll
                    for (int tt = 0; tt < 16; ++tt) { y0[tt] = b0; y1[tt] = b1; }
                    const LAS unsigned* ab = abuf + half * 16 * 512 + tid;
#pragma unroll
                    for (int rr = 0; rr < 46; ++rr) { const unsigned av = ab[rr * 512]; const float a0 = bf_lo(av), a1 = bf_hi(av);
#pragma unroll
                        for (int tt = 0; tt < 16; ++tt) { const int k = rr - tt; if (k >= 0 && k <= 30) { y0[tt] += a0 * w0[k]; y1[tt] += a1 * w1[k]; } } }
                    float ms = 0.f, mq = 0.f;
#pragma unroll
                    for (int tt = 0; tt < 16; ++tt) { float sv = y0[tt] + y1[tt], qv = y0[tt] * y0[tt] + y1[tt] * y1[tt]; sv = wave_sum(sv); qv = wave_sum(qv);
                        ms = (lane == tt) ? sv : ms; mq = (lane == tt) ? qv : mq; }
                    if (lane < 16) { red[(wave * 16 + lane) * 2] = ms; red[(wave * 16 + lane) * 2 + 1] = mq; }
                    __syncthreads();
#pragma unroll
                    for (int tt = 0; tt < 16; ++tt) { float sv = 0.f, qv = 0.f;
#pragma unroll
                        for (int w = 0; w < 8; ++w) { sv += red[(w * 16 + tt) * 2]; qv += red[(w * 16 + tt) * 2 + 1]; }
                        const float mu = sv * (1.0f / 1024.0f), var = qv * (1.0f / 1024.0f) - mu * mu, rstd = __builtin_amdgcn_rsqf(var + EPS);
                        const float v0 = (y0[tt] - mu) * rstd * g0 + e0, v1 = (y1[tt] - mu) * rstd * g1 + e1;
                        *(unsigned*)(MIX + (size_t)(t0 + half * 16 + tt) * DM + c0) = cvt_pk_bf16(siluf_(v0), siluf_(v1)); }
                    __syncthreads();
                }
            }
            __syncthreads();
        }
#endif
        {
            pg8::Gemm g{CQ, WPTR(l, W_QB), 768, 768, 768, 0}; pg8::Order S; S.init(M / 256, 1536 / 256, G, bx);
            pg8::EpiPlain E{QF, 1536, ssq + Z_CQ + l * M, 1.0f / 768.0f};
            pg8::gemm_phase<pg8::EpiPlain, pg8::Order, true, true>(lds, g, S, E);
        }
        {
            pg8::Gemm g{CKV, WPTR(l, W_KVB), 256, 256, 256, 0}; pg8::Order S; S.init(M / 256, 2048 / 256, G, bx);
            pg8::EpiPlain E{KVR, 2048, ssq + Z_CKV + l * M, 1.0f / 256.0f};
            pg8::gemm_phase<pg8::EpiPlain, pg8::Order, true, true>(lds, g, S, E);
        }
        grid.sync(); PHASE_FENCE();
#ifndef NO_PREP
        {
            const float* gq = PARL(l, PAR_QN); const float* gk = PARL(l, PAR_KN); const int* pos = (const int*)(PAR + PAR_POS);
            const float gq0 = gq[2 * lane], gq1 = gq[2 * lane + 1], gqr = gq[128 + lane], gk0 = gk[2 * lane], gk1 = gk[2 * lane + 1], gkr = gk[128 + lane];
            const float invf = INV_FREQ[lane & 31];
            for (int row = gw; row < M; row += NGW) {
                const float ang = (float)pos[row] * invf;
                double rev = (double)ang * 0.15915494309189535; rev -= __builtin_rint(rev);
                const float frv = (float)rev; const float cs = __builtin_amdgcn_cosf(frv), sn = __builtin_amdgcn_sinf(frv);
                const float sgn = (lane < 32) ? -sn : sn;
                const float kraw = bf2f(KPE[(size_t)row * 64 + lane]); const float ssq_pe = wave_sum(kraw * kraw);
                const float ky = kraw * gkr; const float kpart = __shfl_xor(ky, 32); const float krot = ky * cs + kpart * sgn;
#pragma unroll
                for (int h = 0; h < 8; ++h) {
                    const unsigned w = *(const unsigned*)(KVR + (size_t)row * 2048 + h * 256 + 2 * lane); const float v0 = bf_lo(w), v1 = bf_hi(w);
                    const float sq = wave_sum(v0 * v0 + v1 * v1) + ssq_pe; const float rs = rstd_of(sq, 1.0f / 192.0f);
                    *(unsigned*)(KF + (size_t)row * 1536 + h * 192 + 2 * lane) = cvt_pk_bf16(v0 * rs * gk0, v1 * rs * gk1);
                    KF[(size_t)row * 1536 + h * 192 + 128 + lane] = (bf16_t)(cvt_pk_bf16(krot * rs, 0.f) & 0xffffu);
                }
#pragma unroll
                for (int h = 0; h < 8; ++h) {
                    bf16_t* qp = QF + (size_t)row * 1536 + h * 192;
                    const unsigned w = *(const unsigned*)(qp + 2 * lane); const float v0 = bf_lo(w), v1 = bf_hi(w); const float vr = bf2f(qp[128 + lane]);
                    const float sq = wave_sum(v0 * v0 + v1 * v1 + vr * vr); const float rs = rstd_of(sq, 1.0f / 192.0f) * QSCALE;
                    const float qy = vr * gqr; const float qpart = __shfl_xor(qy, 32); const float qrot = qy * cs + qpart * sgn;
                    *(unsigned*)(qp + 2 * lane) = cvt_pk_bf16(v0 * rs * gq0, v1 * rs * gq1);
                    qp[128 + lane] = (bf16_t)(cvt_pk_bf16(qrot * rs, 0.f) & 0xffffu);
                }
            }
        }
#endif
        grid.sync(); PHASE_FENCE();
#ifndef NO_ATTN
        {
            for (int it = vcu; it < 256; it += G) { const int bh = it >> 4, s = it & 15;
                mla::attn_unit(bh >> 3, bh & 7, 31 - s, QF, KF, KVR, MIX, (char*)lds_raw);
                mla::attn_unit(bh >> 3, bh & 7, s, QF, KF, KVR, MIX, (char*)lds_raw); }
        }
#endif
        grid.sync(); PHASE_FENCE();
        {
            pg8::Gemm g{MIX, WPTR(l, W_OUT), DM, DM, DM, 0}; pg8::Order S; S.init(M / 256, DM / 256, G, bx);
            pg8::EpiResid E{(const float*)(GAS float*)out, (float*)(GAS float*)out, XB, ssq + ssqx(4 * l + 2), 1.0f, 1};
            pg8::gemm_phase<pg8::EpiResid, pg8::Order, true, true>(lds, g, S, E);
        }
        grid.sync(); PHASE_FENCE();
        {
            pg8::Gemm g{XB, WPTR(l, W_CQ), DM, DM, DM, 0}; pg8::Order S; S.init(M / 256, DM / 256, G, bx);
            pg8::EpiCq E{QC, ssq + ssqx(4 * l + 2), ssq + Z_QC + l * 4 * M};
            pg8::gemm_phase<pg8::EpiCq, pg8::Order, true, true>(lds, g, S, E);
        }
        grid.sync(); PHASE_FENCE();
        {
            pg8::Gemm g{QC, (bf16_t*)(WSG + WS_KC) + (size_t)l * MMEM * DM, DM, DM, 512, 1};
            pg8::EpiSoftmax E{PC, ssq + Z_QC + l * 4 * M, ssq + Z_KC + l * 2048};
            for (int u = bx; u < 256; u += G) { pg8::SingleOrder S; S.u0.pm = u >> 2; S.u0.pn = u & 3;
                pg8::gemm_phase<pg8::EpiSoftmax, pg8::SingleOrder, false, true>(lds, g, S, E); }
        }
        grid.sync(); PHASE_FENCE();
        {
            pg8::Gemm g{PC, (bf16_t*)(WSG + WS_VT) + (size_t)l * MMEM * DM, 1024, 256, 256, 2}; pg8::Order S; S.init(M / 256, 8, G, bx);
            pg8::EpiPlain E{OC, DM, nullptr, 1.0f};
            pg8::gemm_phase<pg8::EpiPlain, pg8::Order, true, true>(lds, g, S, E);
        }
        grid.sync(); PHASE_FENCE();
        {
            pg8::Gemm g{OC, WPTR(l, W_CO), DM, DM, DM, 0}; pg8::Order S; S.init(M / 256, DM / 256, G, bx);
            pg8::EpiResid E{(const float*)(GAS float*)out, (float*)(GAS float*)out, XB, ssq + ssqx(4 * l + 3), 1.0f, 1};
            pg8::gemm_phase<pg8::EpiResid, pg8::Order, true, true>(lds, g, S, E);
        }
        grid.sync(); PHASE_FENCE();
        {
            pg8::Gemm g{XB, WPTR(l, W_GU2), DM, DM, DM, 0}; pg8::Order S; S.init(M / 256, 2 * DFF / 256, G, bx);
            pg8::EpiGateUp E{HB, ssq + ssqx(4 * l + 3)};
            pg8::gemm_phase<pg8::EpiGateUp, pg8::Order, true, true>(lds, g, S, E);
        }
        grid.sync(); PHASE_FENCE();
        {
            pg8::Gemm g{HB, WPTR(l, W_D2), DFF, DFF, DFF, 0}; pg8::Order S; S.init(M / 256, DM / 256, G, bx);
            pg8::EpiResid E{(const float*)(GAS float*)out, (float*)(GAS float*)out, XB, ssq + ssqx(4 * l + 4), 0.5f, l == 0 ? 1 : 0};
            pg8::gemm_phase<pg8::EpiResid, pg8::Order, true, true>(lds, g, S, E);
        }
        if (l == 0) grid.sync(); PHASE_FENCE();
    }
}

extern "C" void kernel_launch(void* const* d_in, const int* in_sizes, int n_in, void* d_out, int out_size, void* d_ws, size_t ws_size, hipStream_t stream) {
    static int grid = 0;
    if (grid == 0) {
        if (n_in != 32 || out_size != M * DM || ws_size < WS_END) { fprintf(stderr, "kernel_launch: unexpected shapes: n_in %d out %d ws %zu (need %zu)\n", n_in, out_size, ws_size, (size_t)WS_END); grid = -1; return; }
        int dev = 0, cus = 0, per_cu = 0;
        if (hipGetDevice(&dev) != hipSuccess || hipDeviceGetAttribute(&cus, hipDeviceAttributeMultiprocessorCount, dev) != hipSuccess) { grid = -1; return; }
        if (hipFuncSetAttribute((const void*)fwd_megakernel, hipFuncAttributeMaxDynamicSharedMemorySize, LDS_BYTES) != hipSuccess) { fprintf(stderr, "hipFuncSetAttribute failed\n"); grid = -1; return; }
        if (hipOccupancyMaxActiveBlocksPerMultiprocessor(&per_cu, (const void*)fwd_megakernel, 512, LDS_BYTES) != hipSuccess || per_cu < 1) { fprintf(stderr, "occupancy query failed (%d)\n", per_cu); grid = -1; return; }
        grid = cus * per_cu;
    }
    if (grid < 0) return;
    Args a{};
    for (int i = 0; i < 32; ++i) a.in[i] = d_in[i];
    a.out = (float*)d_out; a.ws = (unsigned char*)d_ws;
    void* args[] = {&a};
    hipError_t e = hipLaunchCooperativeKernel((const void*)fwd_megakernel, dim3(grid), dim3(512), args, LDS_BYTES, stream);
    if (e != hipSuccess) fprintf(stderr, "cooperative launch failed: %s (grid %d)\n", hipGetErrorString(e), grid);
}
```

```cpp
#include <hip/hip_runtime.h>
#include <hip/hip_cooperative_groups.h>
#include <cstdio>
#include <cstdint>
namespace cg = cooperative_groups;

#define LAS __attribute__((address_space(3)))
typedef unsigned short bf16_t;
typedef short bf16x8 __attribute__((ext_vector_type(8)));
typedef short s16x4 __attribute__((ext_vector_type(4)));
typedef float f32x4 __attribute__((ext_vector_type(4)));
typedef float f32x16 __attribute__((ext_vector_type(16)));
typedef unsigned u32x4 __attribute__((ext_vector_type(4)));
typedef unsigned u32x2 __attribute__((ext_vector_type(2)));
typedef unsigned long long ssq_t;

constexpr int M = 16384, DM = 2048, DFF = 5632, SEQ = 8192, NMEM = 256, MMEM = 512;
constexpr int NIN = 3136, NINP = 3328;
constexpr float EPS = 1e-6f;
constexpr float LOG2E = 1.4426950408889634f;
constexpr float QSCALE = 0.07216878364870322f * LOG2E;
constexpr float XSCALE = 0.04419417382415922f * LOG2E;

constexpr size_t MiB = 1u << 20;
constexpr size_t WS_SSQ = 760 * MiB;
constexpr size_t WS_W = 2 * MiB, LW = 190 * MiB;
constexpr size_t W_GU1 = 0, W_D1 = 44 * MiB, W_IN = 66 * MiB, W_QB = 79 * MiB, W_KVB = 82 * MiB, W_OUT = 83 * MiB, W_CQ = 91 * MiB,
                 W_CKV = 99 * MiB, W_CO = 115 * MiB, W_GU2 = 123 * MiB, W_D2 = 167 * MiB;
constexpr size_t WS_XB = 382 * MiB, WS_H = 446 * MiB, WS_KVR = 622 * MiB, WS_MIX = 686 * MiB, WS_MEMB = 750 * MiB, WS_KC = 752 * MiB,
                 WS_VT = 756 * MiB, WS_END = 764 * MiB;
constexpr size_t H_AGLU = 0, H_CQ = 32 * MiB, H_CKV = 56 * MiB, H_KPE = 64 * MiB, H_QF = 66 * MiB, H_KF = 114 * MiB;
constexpr size_t H_QC = 0, H_PC = 64 * MiB, H_OC = 96 * MiB;
constexpr int Z_CQ = 8 * M, Z_CKV = 10 * M, Z_QC = 12 * M, Z_KC = 20 * M, ZERO_COUNT = 20 * M + 4096, NZ_X0 = ZERO_COUNT, NZ_MEM = ZERO_COUNT + M;
__device__ __forceinline__ int ssqx(int s) { return s == 0 ? NZ_X0 : (s - 1) * M; }

constexpr size_t WS_PAR = 1536 * 1024;
constexpr int PAR_POS = 0, PAR_L0 = 16384, PAR_LS = 36864, PAR_CONVW = 0, PAR_CONVB = 31744, PAR_LNG = 32768, PAR_LNB = 33792, PAR_QN = 34816, PAR_KN = 35008, PAR_CQN = 35200, PAR_CKN = 35712;
constexpr size_t WS_CTL = 1900 * 1024, CTL_BYTES = 16384;
constexpr int LDS_BYTES = 147456;

__device__ __forceinline__ unsigned cvt_pk_bf16(float lo, float hi) { unsigned r; asm volatile("v_cvt_pk_bf16_f32 %0, %1, %2" : "=v"(r) : "v"(lo), "v"(hi)); return r; }
__device__ __forceinline__ float bf_lo(unsigned w) { return __uint_as_float(w << 16); }
__device__ __forceinline__ float bf_hi(unsigned w) { return __uint_as_float(w & 0xffff0000u); }
__device__ __forceinline__ float bf2f(bf16_t v) { return __uint_as_float(((unsigned)v) << 16); }
__device__ __forceinline__ float wave_sum(float v) {
    v += __int_as_float(__builtin_amdgcn_update_dpp(0, __float_as_int(v), 0xB1, 0xF, 0xF, true));
    v += __int_as_float(__builtin_amdgcn_update_dpp(0, __float_as_int(v), 0x4E, 0xF, 0xF, true));
    v += __int_as_float(__builtin_amdgcn_update_dpp(0, __float_as_int(v), 0x141, 0xF, 0xF, true));
    v += __int_as_float(__builtin_amdgcn_update_dpp(0, __float_as_int(v), 0x140, 0xF, 0xF, true));
    const float a = __int_as_float(__builtin_amdgcn_readlane(__float_as_int(v), 0)), b = __int_as_float(__builtin_amdgcn_readlane(__float_as_int(v), 16));
    const float c = __int_as_float(__builtin_amdgcn_readlane(__float_as_int(v), 32)), d = __int_as_float(__builtin_amdgcn_readlane(__float_as_int(v), 48));
    return (a + b) + (c + d);
}
__device__ __forceinline__ float rstd_of(float ssq, float inv_n) { return __builtin_amdgcn_rsqf(ssq * inv_n + EPS); }
__device__ __forceinline__ float rstd_of(ssq_t v, float inv_n) { return __builtin_amdgcn_rsqf(((float)v * 2.3283064365386963e-10f) * inv_n + EPS); }
__device__ __forceinline__ ssq_t ssq_fix(float s) { return (ssq_t)(s * 4294967296.0f); }
__device__ __forceinline__ float sigmoidf_(float g) { return __builtin_amdgcn_rcpf(1.0f + __builtin_amdgcn_exp2f(-g * LOG2E)); }
__device__ __forceinline__ float siluf_(float g) { return g * sigmoidf_(g); }
#define LDS_WAIT() asm volatile("s_waitcnt lgkmcnt(0)" ::: "memory")
#define VM_WAIT() asm volatile("s_waitcnt vmcnt(0)" ::: "memory")

namespace pg8 {
constexpr int BM = 256, BK = 64, HALF = 128, HTB = HALF * BK * 2, STAGE_BYTES = 8 * HTB, NXCD = 8, WGM = 8;
__host__ __device__ __forceinline__ int lds_byte(int r, int c) { const int st = (r >> 4) * 2 + (c >> 5), rr = r & 15, cc = c & 31, ob = rr * 64 + cc * 2; return st * 1024 + (ob ^ (((ob >> 9) & 1) << 5)); }
__host__ __device__ __forceinline__ void stage_rc(int b, int& R, int& C) { const int st = b / 1024, sb = b % 1024, swz = sb ^ (((sb >> 9) & 1) << 5); R = (st >> 1) * 16 + swz / 64; C = (st & 1) * 32 + (swz % 64) / 2; }
__host__ __device__ __forceinline__ int perm32(int rho) { const int n = rho >> 4, i = rho & 15; return 8 * (i >> 2) + 4 * n + (i & 3); }

struct Unit { int pm, pn; };
struct Gemm { const bf16_t* A; const bf16_t* Bt; int lda, ldb, K, mode; };
__device__ __forceinline__ void unit_ptrs(const Gemm& g, const Unit& u, const char*& pa, const char*& pb) {
    size_t ao, bo;
    if (g.mode == 0) { ao = (size_t)u.pm * 256 * g.lda; bo = (size_t)u.pn * 256 * g.ldb; }
    else if (g.mode == 1) { ao = (size_t)u.pm * 256 * g.lda + (size_t)u.pn * 512; bo = (size_t)(u.pm >> 5) * 256 * g.ldb + (size_t)u.pn * 512; }
    else { const int h = u.pn >> 1, dt = u.pn & 1; ao = (size_t)u.pm * 256 * g.lda + (size_t)h * 256; bo = (size_t)((((u.pm >> 5) * 4 + h) * 512) + dt * 256) * g.ldb; }
    pa = (const char*)g.A + ao * 2; pb = (const char*)g.Bt + bo * 2;
}
struct Order {
    int nM, nN, nwg, G, c;
    __device__ __forceinline__ void init(int nM_, int nN_, int G_, int c_) { nM = nM_; nN = nN_; nwg = nM * nN; G = G_; c = c_; }
    __device__ __forceinline__ bool next(int i, Unit& u) const {
        const long L = (long)i * G + c; if (L >= nwg) return false;
        int wgid = (int)L; { const int q = nwg / NXCD, r = nwg % NXCD, xcd = wgid % NXCD, off = wgid / NXCD; wgid = (xcd < r ? xcd * (q + 1) : r * (q + 1) + (xcd - r) * q) + off; }
        const int nig = WGM * nN, gid = wgid / nig, fm = gid * WGM, gsz = (nM - fm) < WGM ? (nM - fm) : WGM;
        u.pm = fm + ((wgid % nig) % gsz); u.pn = (wgid % nig) / gsz; return true;
    }
};
struct SingleOrder {
    Unit u0;
    __device__ __forceinline__ bool next(int i, Unit& u) const { if (i != 0) return false; u = u0; return true; }
};

template <class Epi, class Sched, bool ALIGN_EPI, bool SP2>
__device__ __forceinline__ void gemm_phase(LAS unsigned char* lds, const Gemm g, const Sched& S, const Epi& E) {
    int tid_ = threadIdx.x; asm volatile("" : "+v"(tid_));
    const int tid = tid_, wid = __builtin_amdgcn_readfirstlane(tid >> 6), lane = tid & 63, wr = wid >> 2, wc = wid & 3, fr = lane & 15, fq = lane >> 4;
    const int K = g.K, nt = K / BK;
    unsigned voffA[2], voffB[2];
#pragma unroll
    for (int i = 0; i < 2; ++i) { int R, C; stage_rc(tid * 16 + i * 8192, R, C); const int Rb = Epi::PERM ? ((R & ~31) + perm32(R & 31)) : R;
        voffA[i] = (unsigned)(R * g.lda + C) * 2u; voffB[i] = (unsigned)(Rb * g.ldb + C) * 2u; }
    const size_t kstep = (size_t)(BK * 2);
    const size_t hstepA = (size_t)HALF * g.lda * 2, hstepB = (size_t)HALF * g.ldb * 2;
    const unsigned ldsw = (unsigned)wid * 1024u;
    const int aoff = lds_byte(wr * 64 + fr, fq * 8), boff = lds_byte(wc * 32 + fr, fq * 8);
#define PG8_SA(b, h) (((b) * 2 + (h)) * HTB)
#define PG8_SB(b, h) ((4 + (b) * 2 + (h)) * HTB)
#define PG8_STAGE(bufoff, gbase, voff) do { _Pragma("unroll") for (int _i = 0; _i < 2; ++_i) \
        __builtin_amdgcn_global_load_lds((const unsigned*)((const char*)(gbase) + (voff)[_i]), (LAS unsigned*)(lds + (bufoff) + ldsw + _i * 8192), 16, 0, 0); } while (0)
#define PG8_LDA(dst, b, h) do { _Pragma("unroll") for (int m = 0; m < 4; ++m) _Pragma("unroll") for (int k = 0; k < 2; ++k) dst[m][k] = *(const LAS bf16x8*)(lds + PG8_SA(b, h) + aoff + m * 2048 + k * 1024); } while (0)
#define PG8_LDB(dst, b, h) do { _Pragma("unroll") for (int n = 0; n < 2; ++n) _Pragma("unroll") for (int k = 0; k < 2; ++k) dst[n][k] = *(const LAS bf16x8*)(lds + PG8_SB(b, h) + boff + n * 2048 + k * 1024); } while (0)
#define PG8_MMA(ai, bj, At, Bt) do { __builtin_amdgcn_s_setprio(1); _Pragma("unroll") for (int m = 0; m < 4; ++m) _Pragma("unroll") for (int n = 0; n < 2; ++n) _Pragma("unroll") for (int k = 0; k < 2; ++k) \
        acc[ai][bj][m][n] = __builtin_amdgcn_mfma_f32_16x16x32_bf16(Bt[n][k], At[m][k], acc[ai][bj][m][n], 0, 0, 0); __builtin_amdgcn_s_setprio(0); } while (0)
#define PG8_WAIT_V(n) asm volatile("s_waitcnt vmcnt(" #n ")" ::: "memory")
#define PG8_WAIT_L(n) asm volatile("s_waitcnt lgkmcnt(" #n ")" ::: "memory")
#define PG8_BAR __builtin_amdgcn_s_barrier()
#define PG8_SCHED __builtin_amdgcn_sched_barrier(0)
    Unit cur, nxt; int ui = 0;
    if (!S.next(0, cur)) return;
    f32x4 acc[2][2][4][2];
#pragma unroll
    for (int a = 0; a < 2; ++a)
#pragma unroll
        for (int b = 0; b < 2; ++b)
#pragma unroll
            for (int m = 0; m < 4; ++m)
#pragma unroll
                for (int n = 0; n < 2; ++n) acc[a][b][m][n] = (f32x4){0.f, 0.f, 0.f, 0.f};
    bf16x8 At[4][2], B0[2][2], B1[2][2];
    const char* cA; const char* cB; unit_ptrs(g, cur, cA, cB);
    if constexpr (SP2) {
        PG8_STAGE(PG8_SB(0, 0), cB, voffB); PG8_STAGE(PG8_SB(0, 1), cB + hstepB, voffB); PG8_STAGE(PG8_SA(0, 0), cA, voffA); PG8_STAGE(PG8_SA(0, 1), cA + hstepA, voffA);
        if (wr == 1) PG8_BAR;
        PG8_WAIT_V(2); PG8_BAR;
        PG8_STAGE(PG8_SB(1, 0), cB + kstep, voffB); PG8_STAGE(PG8_SA(1, 0), cA + kstep, voffA); PG8_STAGE(PG8_SB(1, 1), cB + hstepB + kstep, voffB);
        PG8_WAIT_V(6); PG8_BAR;
    } else {
        PG8_STAGE(PG8_SB(0, 0), cB, voffB); PG8_STAGE(PG8_SA(0, 0), cA, voffA); PG8_STAGE(PG8_SB(0, 1), cB + hstepB, voffB); PG8_STAGE(PG8_SA(0, 1), cA + hstepA, voffA);
        if (wr == 1) PG8_BAR;
        PG8_WAIT_V(4); PG8_BAR;
        PG8_STAGE(PG8_SB(1, 0), cB + kstep, voffB); PG8_STAGE(PG8_SA(1, 0), cA + kstep, voffA); PG8_STAGE(PG8_SB(1, 1), cB + hstepB + kstep, voffB);
        PG8_WAIT_V(6); PG8_BAR;
    }
    for (;;) {
        const bool has_next = S.next(ui + 1, nxt);
        const char* nA = cA; const char* nB = cB; if (has_next) unit_ptrs(g, nxt, nA, nB);
        for (int t = 0; t < nt; t += 2) {
            const bool last = (t == nt - 2);
            const char* a1 = cA + (size_t)(t + 1) * kstep;
            const char* a2 = last ? nA : cA + (size_t)(t + 2) * kstep; const char* b2 = last ? nB : cB + (size_t)(t + 2) * kstep;
            const char* a3 = a2 + kstep; const char* b3 = b2 + kstep;
            if constexpr (SP2) {
            PG8_LDB(B0, 0, 0); PG8_LDB(B1, 0, 1); PG8_SCHED; PG8_LDA(At, 0, 0); PG8_STAGE(PG8_SA(1, 1), a1 + hstepA, voffA);
            PG8_WAIT_V(8); PG8_WAIT_L(0); PG8_BAR; PG8_MMA(0, 0, At, B0); PG8_MMA(0, 1, At, B1); PG8_BAR; PG8_SCHED;
            PG8_LDA(At, 0, 1); PG8_STAGE(PG8_SB(0, 0), b2, voffB); PG8_STAGE(PG8_SB(0, 1), b2 + hstepB, voffB); PG8_STAGE(PG8_SA(0, 0), a2, voffA);
            PG8_WAIT_V(8); PG8_WAIT_L(0); PG8_BAR; PG8_MMA(1, 0, At, B0); PG8_MMA(1, 1, At, B1); PG8_BAR; PG8_SCHED;
            PG8_LDB(B0, 1, 0); PG8_LDB(B1, 1, 1); PG8_SCHED; PG8_LDA(At, 1, 0); PG8_STAGE(PG8_SA(0, 1), a2 + hstepA, voffA);
            PG8_WAIT_V(8); PG8_WAIT_L(0); PG8_BAR; PG8_MMA(0, 0, At, B0); PG8_MMA(0, 1, At, B1); PG8_BAR; PG8_SCHED;
            PG8_LDA(At, 1, 1); PG8_STAGE(PG8_SB(1, 0), b3, voffB); PG8_STAGE(PG8_SB(1, 1), b3 + hstepB, voffB); PG8_STAGE(PG8_SA(1, 0), a3, voffA);
            PG8_WAIT_V(8); PG8_WAIT_L(0); PG8_BAR; PG8_MMA(1, 0, At, B0); PG8_MMA(1, 1, At, B1); PG8_BAR; PG8_SCHED;
            } else {
            PG8_LDB(B0, 0, 0); PG8_SCHED; PG8_LDA(At, 0, 0); PG8_STAGE(PG8_SA(1, 1), a1 + hstepA, voffA);
            PG8_WAIT_L(8); PG8_BAR; PG8_WAIT_L(0); PG8_MMA(0, 0, At, B0); PG8_BAR; PG8_SCHED;
            PG8_LDB(B1, 0, 1); PG8_STAGE(PG8_SB(0, 0), b2, voffB);
            PG8_BAR; PG8_WAIT_L(0); PG8_MMA(0, 1, At, B1); PG8_BAR;
            PG8_LDA(At, 0, 1); PG8_STAGE(PG8_SA(0, 0), a2, voffA);
            PG8_BAR; PG8_WAIT_L(0); PG8_MMA(1, 0, At, B0); PG8_BAR; PG8_SCHED;
            PG8_STAGE(PG8_SB(0, 1), b2 + hstepB, voffB);
            PG8_WAIT_V(6); PG8_BAR; PG8_MMA(1, 1, At, B1); PG8_BAR;
            PG8_LDB(B0, 1, 0); PG8_SCHED; PG8_LDA(At, 1, 0); PG8_STAGE(PG8_SA(0, 1), a2 + hstepA, voffA);
            PG8_WAIT_L(8); PG8_BAR; PG8_WAIT_L(0); PG8_MMA(0, 0, At, B0); PG8_BAR; PG8_SCHED;
            PG8_LDB(B1, 1, 1); PG8_STAGE(PG8_SB(1, 0), b3, voffB);
            PG8_BAR; PG8_WAIT_L(0); PG8_MMA(0, 1, At, B1); PG8_BAR;
            PG8_LDA(At, 1, 1); PG8_STAGE(PG8_SA(1, 0), a3, voffA);
            PG8_BAR; PG8_WAIT_L(0); PG8_MMA(1, 0, At, B0); PG8_BAR; PG8_SCHED;
            PG8_STAGE(PG8_SB(1, 1), b3 + hstepB, voffB);
            PG8_WAIT_V(6); PG8_BAR; PG8_MMA(1, 1, At, B1); PG8_BAR;
            }
        }
        if constexpr (ALIGN_EPI) { if (wr == 0) PG8_BAR; }
        if constexpr (!Epi::AFTER_DRAIN) { E(acc, cur, wr, wc, fr, fq); }
        if (!has_next) break;
#pragma unroll
        for (int a = 0; a < 2; ++a)
#pragma unroll
            for (int b = 0; b < 2; ++b)
#pragma unroll
                for (int m = 0; m < 4; ++m)
#pragma unroll
                    for (int n = 0; n < 2; ++n) acc[a][b][m][n] = (f32x4){0.f, 0.f, 0.f, 0.f};
        cur = nxt; cA = nA; cB = nB; ++ui;
        if constexpr (ALIGN_EPI) { if (wr == 1) PG8_BAR; }
    }
    PG8_WAIT_V(0);
    if constexpr (!ALIGN_EPI) { if (wr == 0) PG8_BAR; }
    PG8_BAR;
    if constexpr (Epi::AFTER_DRAIN) { E.fused(acc, cur, wr, wc, fr, fq, lds, wid, lane); }
#undef PG8_SA
#undef PG8_SB
#undef PG8_STAGE
#undef PG8_LDA
#undef PG8_LDB
#undef PG8_MMA
#undef PG8_WAIT_V
#undef PG8_WAIT_L
#undef PG8_BAR
#undef PG8_SCHED
}

typedef f32x4 Acc[2][2][4][2];
#define PACK8(v0, v1) (u32x4){cvt_pk_bf16((v0)[0], (v0)[1]), cvt_pk_bf16((v0)[2], (v0)[3]), cvt_pk_bf16((v1)[0], (v1)[1]), cvt_pk_bf16((v1)[2], (v1)[3])}

struct EpiGateUp {
    static constexpr bool PERM = true, AFTER_DRAIN = false;
    bf16_t* H; const ssq_t* ssq;
    __device__ __forceinline__ void operator()(const Acc& acc, const Unit& u, int wr, int wc, int fr, int fq) const {
        const int row0 = u.pm * BM + wr * 64 + fr, col0 = u.pn * 128 + wc * 32 + 8 * fq;
        ssq_t rsv[2][4];
#pragma unroll
        for (int ai = 0; ai < 2; ++ai)
#pragma unroll
            for (int m = 0; m < 4; ++m) rsv[ai][m] = ssq[row0 + ai * HALF + m * 16];
#pragma unroll
        for (int ai = 0; ai < 2; ++ai)
#pragma unroll
            for (int m = 0; m < 4; ++m) { const int r = row0 + ai * HALF + m * 16; const float rs = rstd_of(rsv[ai][m], 1.0f / 2048.0f);
                f32x4 o[2];
#pragma unroll
                for (int n = 0; n < 2; ++n)
#pragma unroll
                    for (int i = 0; i < 4; ++i) { const float gt = acc[ai][0][m][n][i] * rs, up = acc[ai][1][m][n][i] * rs; o[n][i] = siluf_(gt) * up; }
                *(u32x4*)(H + (size_t)r * DFF + col0) = PACK8(o[0], o[1]); }
    }
};
struct EpiResid {
    static constexpr bool PERM = false, AFTER_DRAIN = false;
    const float* xsrc; float* xdst; bf16_t* xb; ssq_t* ssq_out; float alpha; int want_next;
    __device__ __forceinline__ void operator()(const Acc& acc, const Unit& u, int wr, int wc, int fr, int fq) const {
        const int row0 = u.pm * BM + wr * 64 + fr, col0 = u.pn * BM + wc * 32 + 4 * fq;
        f32x4 xv[2][2][2];
#define RES_LOAD(buf, g_) do { const size_t off_ = (size_t)(row0 + ((g_) >> 2) * HALF + ((g_) & 3) * 16) * DM + col0; \
        _Pragma("unroll") for (int bj = 0; bj < 2; ++bj) _Pragma("unroll") for (int n = 0; n < 2; ++n) xv[buf][bj][n] = *(const f32x4*)(xsrc + off_ + bj * HALF + n * 16); } while (0)
        RES_LOAD(0, 0);
#pragma unroll
        for (int g_ = 0; g_ < 8; ++g_) { const int ai = g_ >> 2, m = g_ & 3, r = row0 + ai * HALF + m * 16; const size_t off = (size_t)r * DM + col0; float s = 0.f;
            if (g_ + 1 < 8) RES_LOAD((g_ + 1) & 1, g_ + 1);
#pragma unroll
            for (int bj = 0; bj < 2; ++bj)
#pragma unroll
                for (int n = 0; n < 2; ++n) { const size_t o2 = off + bj * HALF + n * 16; const f32x4 o = xv[g_ & 1][bj][n] + acc[ai][bj][m][n] * alpha;
                    *(f32x4*)(xdst + o2) = o;
                    if (want_next) { s += (o[0] * o[0] + o[1] * o[1]) + (o[2] * o[2] + o[3] * o[3]); *(u32x2*)(xb + o2) = (u32x2){cvt_pk_bf16(o[0], o[1]), cvt_pk_bf16(o[2], o[3])}; } }
            if (want_next) { s += __shfl_xor(s, 16); s += __shfl_xor(s, 32); if (fq == 0) atomicAdd(ssq_out + r, ssq_fix(s)); } }
#undef RES_LOAD
    }
};
struct EpiWin {
    static constexpr bool PERM = true, AFTER_DRAIN = false;
    const ssq_t* ssq; bf16_t* AGLU; bf16_t* CQ; bf16_t* CKV; bf16_t* KPE; ssq_t* ssq_cq; ssq_t* ssq_ckv;
    __device__ __forceinline__ void operator()(const Acc& acc, const Unit& u, int wr, int wc, int fr, int fq) const {
        const int row0 = u.pm * BM + wr * 64 + fr, cw = wc * 32 + 8 * fq, pn = u.pn;
        ssq_t rsv[2][4];
#pragma unroll
        for (int ai = 0; ai < 2; ++ai)
#pragma unroll
            for (int m = 0; m < 4; ++m) rsv[ai][m] = ssq[row0 + ai * HALF + m * 16];
#pragma unroll
        for (int ai = 0; ai < 2; ++ai)
#pragma unroll
            for (int m = 0; m < 4; ++m) { const int r = row0 + ai * HALF + m * 16; const float rs = rstd_of(rsv[ai][m], 1.0f / 2048.0f);
                if (pn < 8) {
                    f32x4 o[2];
#pragma unroll
                    for (int n = 0; n < 2; ++n)
#pragma unroll
                        for (int i = 0; i < 4; ++i) o[n][i] = (acc[ai][0][m][n][i] * rs) * sigmoidf_(acc[ai][1][m][n][i] * rs);
                    *(u32x4*)(AGLU + (size_t)r * 1024 + pn * 128 + cw) = PACK8(o[0], o[1]);
                } else if (pn < 12) {
                    float s = 0.f;
#pragma unroll
                    for (int bj = 0; bj < 2; ++bj) { const f32x4 v0 = acc[ai][bj][m][0] * rs, v1 = acc[ai][bj][m][1] * rs;
                        s += (v0[0] * v0[0] + v0[1] * v0[1]) + (v0[2] * v0[2] + v0[3] * v0[3]) + (v1[0] * v1[0] + v1[1] * v1[1]) + (v1[2] * v1[2] + v1[3] * v1[3]);
                        if (pn < 11) *(u32x4*)(CQ + (size_t)r * 768 + (pn - 8) * 256 + bj * HALF + cw) = PACK8(v0, v1);
                        else *(u32x4*)(CKV + (size_t)r * 256 + bj * HALF + cw) = PACK8(v0, v1); }
                    s += __shfl_xor(s, 16); s += __shfl_xor(s, 32);
                    if (fq == 0) atomicAdd((pn < 11 ? ssq_cq : ssq_ckv) + r, ssq_fix(s));
                } else {
                    if (wc < 2) { const f32x4 v0 = acc[ai][0][m][0] * rs, v1 = acc[ai][0][m][1] * rs; *(u32x4*)(KPE + (size_t)r * 64 + cw) = PACK8(v0, v1); }
                } }
    }
};
struct EpiPlain {
    static constexpr bool PERM = true, AFTER_DRAIN = false;
    bf16_t* O; int ldc; const ssq_t* ssq; float inv_n;
    __device__ __forceinline__ void operator()(const Acc& acc, const Unit& u, int wr, int wc, int fr, int fq) const {
        const int row0 = u.pm * BM + wr * 64 + fr, col0 = u.pn * BM + wc * 32 + 8 * fq;
        ssq_t rsv[2][4];
#pragma unroll
        for (int ai = 0; ai < 2; ++ai)
#pragma unroll
            for (int m = 0; m < 4; ++m) rsv[ai][m] = ssq ? ssq[row0 + ai * HALF + m * 16] : (ssq_t)0;
#pragma unroll
        for (int ai = 0; ai < 2; ++ai)
#pragma unroll
            for (int m = 0; m < 4; ++m) { const int r = row0 + ai * HALF + m * 16; const float rs = ssq ? rstd_of(rsv[ai][m], inv_n) : 1.0f;
#pragma unroll
                for (int bj = 0; bj < 2; ++bj) { const f32x4 v0 = acc[ai][bj][m][0] * rs, v1 = acc[ai][bj][m][1] * rs; *(u32x4*)(O + (size_t)r * ldc + col0 + bj * HALF) = PACK8(v0, v1); } }
    }
};
struct EpiCq {
    static constexpr bool PERM = true, AFTER_DRAIN = false;
    bf16_t* QC; const ssq_t* ssq; ssq_t* ssq_qc;
    __device__ __forceinline__ void operator()(const Acc& acc, const Unit& u, int wr, int wc, int fr, int fq) const {
        const int row0 = u.pm * BM + wr * 64 + fr, col0 = u.pn * BM + wc * 32 + 8 * fq, head = u.pn >> 1;
        ssq_t rsv[2][4];
#pragma unroll
        for (int ai = 0; ai < 2; ++ai)
#pragma unroll
            for (int m = 0; m < 4; ++m) rsv[ai][m] = ssq[row0 + ai * HALF + m * 16];
#pragma unroll
        for (int ai = 0; ai < 2; ++ai)
#pragma unroll
            for (int m = 0; m < 4; ++m) { const int r = row0 + ai * HALF + m * 16; const float rs = rstd_of(rsv[ai][m], 1.0f / 2048.0f); float s = 0.f;
#pragma unroll
                for (int bj = 0; bj < 2; ++bj) { const f32x4 v0 = acc[ai][bj][m][0] * rs, v1 = acc[ai][bj][m][1] * rs;
                    s += (v0[0] * v0[0] + v0[1] * v0[1]) + (v0[2] * v0[2] + v0[3] * v0[3]) + (v1[0] * v1[0] + v1[1] * v1[1]) + (v1[2] * v1[2] + v1[3] * v1[3]);
                    *(u32x4*)(QC + (size_t)r * DM + col0 + bj * HALF) = PACK8(v0, v1); }
                s += __shfl_xor(s, 16); s += __shfl_xor(s, 32);
                if (fq == 0) atomicAdd(ssq_qc + r * 4 + head, ssq_fix(s)); }
    }
};
struct EpiMemKV {
    static constexpr bool PERM = true, AFTER_DRAIN = false;
    const ssq_t* ssq_mem; const float* gq; const float* gk; bf16_t* KC; bf16_t* VT; ssq_t* ssq_kc;
    __device__ __forceinline__ void operator()(const Acc& acc, const Unit& u, int wr, int wc, int fr, int fq) const {
        const int row0 = u.pm * BM + wr * 64 + fr, pn = u.pn;
#pragma unroll
        for (int ai = 0; ai < 2; ++ai)
#pragma unroll
            for (int m = 0; m < 4; ++m) { const int r = row0 + ai * HALF + m * 16; const float rs = rstd_of(ssq_mem[r], 1.0f / 2048.0f);
                if (pn < 8) { float s = 0.f;
#pragma unroll
                    for (int bj = 0; bj < 2; ++bj) { const int col = pn * BM + bj * HALF + wc * 32 + 8 * fq, d = col & 511; f32x4 v[2];
#pragma unroll
                        for (int n = 0; n < 2; ++n) { v[n] = acc[ai][bj][m][n] * rs; s += (v[n][0] * v[n][0] + v[n][1] * v[n][1]) + (v[n][2] * v[n][2] + v[n][3] * v[n][3]);
                            const f32x4 a = *(const f32x4*)(gq + d + 4 * n), b = *(const f32x4*)(gk + d + 4 * n); v[n] = v[n] * a * b; }
                        *(u32x4*)(KC + (size_t)r * DM + col) = PACK8(v[0], v[1]); }
                    s += __shfl_xor(s, 16); s += __shfl_xor(s, 32);
                    if (fq == 0) atomicAdd(ssq_kc + r * 4 + (pn >> 1), ssq_fix(s));
                } else {
                    const int b = r >> 8, mm = r & 255;
#pragma unroll
                    for (int bj = 0; bj < 2; ++bj)
#pragma unroll
                        for (int n = 0; n < 2; ++n)
#pragma unroll
                            for (int i = 0; i < 4; ++i) { const int col = (pn - 8) * BM + bj * HALF + wc * 32 + 8 * fq + 4 * n + i, h = col >> 9, d = col & 511;
                                VT[((size_t)((b * 4 + h) * 512 + d)) * 256 + mm] = (bf16_t)(cvt_pk_bf16(acc[ai][bj][m][n][i] * rs, 0.f) & 0xffffu); }
                } }
    }
};
struct EpiSoftmax {
    static constexpr bool PERM = true, AFTER_DRAIN = true;
    bf16_t* P; const ssq_t* ssq_qc; const ssq_t* ssq_kc;
    __device__ __forceinline__ void fused(Acc& acc, const Unit& u, int wr, int wc, int fr, int fq, LAS unsigned char* lds, int wid, int lane) const {
        LAS float* X = (LAS float*)lds; LAS float* Y = X + 1024;
        const int h = u.pn, b = u.pm >> 5;
        f32x4 rk[2][2];
#pragma unroll
        for (int bj = 0; bj < 2; ++bj)
#pragma unroll
            for (int n = 0; n < 2; ++n)
#pragma unroll
                for (int i = 0; i < 4; ++i) { const int mm = bj * HALF + wc * 32 + 8 * fq + 4 * n + i; rk[bj][n][i] = rstd_of(ssq_kc[(b * 256 + mm) * 4 + h], 1.0f / 512.0f) * XSCALE; }
#pragma unroll
        for (int ai = 0; ai < 2; ++ai)
#pragma unroll
            for (int m = 0; m < 4; ++m) { const int rl = ai * HALF + wr * 64 + m * 16 + fr, r = u.pm * BM + rl; const float rq = rstd_of(ssq_qc[r * 4 + h], 1.0f / 512.0f); float mx = -3.0e38f;
#pragma unroll
                for (int bj = 0; bj < 2; ++bj)
#pragma unroll
                    for (int n = 0; n < 2; ++n) { const f32x4 v = acc[ai][bj][m][n] * rk[bj][n] * rq; acc[ai][bj][m][n] = v; mx = fmaxf(fmaxf(mx, fmaxf(v[0], v[1])), fmaxf(v[2], v[3])); }
                mx = fmaxf(mx, __shfl_xor(mx, 16)); mx = fmaxf(mx, __shfl_xor(mx, 32));
                if (fq == 0) X[rl * 4 + wc] = mx; }
        LDS_WAIT(); __builtin_amdgcn_s_barrier(); asm volatile("" ::: "memory");
#pragma unroll
        for (int ai = 0; ai < 2; ++ai)
#pragma unroll
            for (int m = 0; m < 4; ++m) { const int rl = ai * HALF + wr * 64 + m * 16 + fr; const float mx = fmaxf(fmaxf(X[rl * 4 + 0], X[rl * 4 + 1]), fmaxf(X[rl * 4 + 2], X[rl * 4 + 3])); float s = 0.f;
#pragma unroll
                for (int bj = 0; bj < 2; ++bj)
#pragma unroll
                    for (int n = 0; n < 2; ++n) { f32x4 v = acc[ai][bj][m][n];
#pragma unroll
                        for (int i = 0; i < 4; ++i) { v[i] = __builtin_amdgcn_exp2f(v[i] - mx); s += v[i]; }
                        acc[ai][bj][m][n] = v; }
                s += __shfl_xor(s, 16); s += __shfl_xor(s, 32);
                if (fq == 0) Y[rl * 4 + wc] = s; }
        LDS_WAIT(); __builtin_amdgcn_s_barrier(); asm volatile("" ::: "memory");
#pragma unroll
        for (int ai = 0; ai < 2; ++ai)
#pragma unroll
            for (int m = 0; m < 4; ++m) { const int rl = ai * HALF + wr * 64 + m * 16 + fr, r = u.pm * BM + rl; const float inv = 1.0f / ((Y[rl * 4 + 0] + Y[rl * 4 + 1]) + (Y[rl * 4 + 2] + Y[rl * 4 + 3]));
#pragma unroll
                for (int bj = 0; bj < 2; ++bj) { const f32x4 v0 = acc[ai][bj][m][0] * inv, v1 = acc[ai][bj][m][1] * inv;
                    *(u32x4*)(P + (size_t)r * 1024 + h * 256 + bj * HALF + wc * 32 + 8 * fq) = PACK8(v0, v1); } }
        LDS_WAIT(); __builtin_amdgcn_s_barrier(); asm volatile("" ::: "memory");
    }
};
}

namespace mla {
constexpr int NW = 8, QBLK = 32, KVBLK = 64, LDQ = 1536, LDK = 1536, LDV = 2048, LDO = 2048;
constexpr int SHM_V = 64 * 128 * 2, SHM_K = 64 * 192 * 2, SHM_ATTN = 4 * SHM_V + 3 * SHM_K + NW * 64 * 4;
constexpr float THRL = 8.0f;
#define KSWZ(row, colB) ((row) * 384 + ((colB) ^ ((((row) >> 1) & 7) << 4)))
#define SBAR() __builtin_amdgcn_sched_barrier(0)
__device__ __forceinline__ int crow(int r, int hi) { return (r & 3) + 8 * (r >> 2) + 4 * hi; }
__device__ __forceinline__ int v_st(int k, int c) { const int kk = (k & ~0xC) | ((k & 4) << 1) | ((k & 8) >> 1); return ((kk >> 3) * 4 + (c >> 5)) * 512 + ((kk & 7) * 32 + (c & 31)) * 2; }
__device__ __forceinline__ int v_rd_base(int lane) { return ((lane & 3) << 3) | (((lane >> 2) & 3) << 6) | (((lane >> 4) & 1) << 5) | (((lane >> 5) & 1) << 8); }
constexpr int v_rd_off(int d0, int ks, int half) { return d0 * 512 + ks * 4096 + half * 2048; }
template <int OFF> __device__ __forceinline__ s16x4 tr_read(int vb) {
    s16x4 r; asm volatile("ds_read_b64_tr_b16 %0, %1 offset:%2" : "=&v"(r) : "v"(vb), "i"(OFF) : "memory"); return r;
}
template <int D0> __device__ __forceinline__ void pv_one(f32x16& od, int vb, bf16x8 pa0, bf16x8 pa1, bf16x8 pa2, bf16x8 pa3) {
    const s16x4 l0 = tr_read<v_rd_off(D0, 0, 0)>(vb), h0 = tr_read<v_rd_off(D0, 0, 1)>(vb), l1 = tr_read<v_rd_off(D0, 1, 0)>(vb), h1 = tr_read<v_rd_off(D0, 1, 1)>(vb);
    const s16x4 l2 = tr_read<v_rd_off(D0, 2, 0)>(vb), h2 = tr_read<v_rd_off(D0, 2, 1)>(vb), l3 = tr_read<v_rd_off(D0, 3, 0)>(vb), h3 = tr_read<v_rd_off(D0, 3, 1)>(vb);
    asm volatile("s_waitcnt lgkmcnt(0)" ::: "memory"); SBAR();
#define PK(L, H) (bf16x8){L[0], L[1], L[2], L[3], H[0], H[1], H[2], H[3]}
    od = __builtin_amdgcn_mfma_f32_32x32x16_bf16(pa0, PK(l0, h0), od, 0, 0, 0);
    od = __builtin_amdgcn_mfma_f32_32x32x16_bf16(pa1, PK(l1, h1), od, 0, 0, 0);
    od = __builtin_amdgcn_mfma_f32_32x32x16_bf16(pa2, PK(l2, h2), od, 0, 0, 0);
    od = __builtin_amdgcn_mfma_f32_32x32x16_bf16(pa3, PK(l3, h3), od, 0, 0, 0);
#undef PK
}
__device__ __forceinline__ void sm_pv(f32x16& p0, f32x16& p1, float& m_reg, float& l_reg, f32x16 (&o)[4], float* al_l, int vb, int r32, int hi, bool first) {
    float pmax = p0[0];
#pragma unroll
    for (int r = 1; r < 16; ++r) pmax = fmaxf(pmax, p0[r]);
#pragma unroll
    for (int r = 0; r < 16; ++r) pmax = fmaxf(pmax, p1[r]);
    { auto rr = __builtin_amdgcn_permlane32_swap(__float_as_uint(pmax), __float_as_uint(pmax), false, false);
      pmax = fmaxf(__uint_as_float(rr[0]), __uint_as_float(rr[1])); }
    if (first) {
        m_reg += pmax;
#pragma unroll
        for (int r = 0; r < 16; ++r) { p0[r] -= pmax; p1[r] -= pmax; }
    } else if (!__all(pmax <= THRL)) {
        const float dl = fmaxf(pmax, 0.f); const float alpha = __builtin_amdgcn_exp2f(-dl); m_reg += dl; l_reg *= alpha;
#pragma unroll
        for (int r = 0; r < 16; ++r) { p0[r] -= dl; p1[r] -= dl; }
        if (hi == 0) al_l[r32] = alpha;
        LDS_WAIT();
#pragma unroll
        for (int d = 0; d < 4; ++d)
#pragma unroll
            for (int r = 0; r < 16; ++r) o[d][r] *= al_l[crow(r, hi)];
    }
#pragma unroll
    for (int r = 0; r < 16; ++r) { p0[r] = __builtin_amdgcn_exp2f(p0[r]); p1[r] = __builtin_amdgcn_exp2f(p1[r]); }
    typedef float f32x2v __attribute__((ext_vector_type(2)));
    f32x2v ps2 = (f32x2v){0.f, 0.f};
#pragma unroll
    for (int r = 0; r < 16; r += 2) { ps2 += (f32x2v){p0[r], p0[r + 1]}; ps2 += (f32x2v){p1[r], p1[r + 1]}; }
    float ps = ps2.x + ps2.y;
    { auto rr = __builtin_amdgcn_permlane32_swap(__float_as_uint(ps), __float_as_uint(ps), false, false);
      ps = __uint_as_float(rr[0]) + __uint_as_float(rr[1]); }
    l_reg += ps;
    bf16x8 pa0, pa1, pa2, pa3;
#define PK4(P, BASE, OUT) do { unsigned a0 = cvt_pk_bf16(P[BASE + 0], P[BASE + 1]), a1 = cvt_pk_bf16(P[BASE + 2], P[BASE + 3]);   \
    unsigned b0 = cvt_pk_bf16(P[BASE + 4], P[BASE + 5]), b1 = cvt_pk_bf16(P[BASE + 6], P[BASE + 7]);                              \
    auto r0 = __builtin_amdgcn_permlane32_swap(a0, b0, false, false); auto r1 = __builtin_amdgcn_permlane32_swap(a1, b1, false, false); \
    u32x4 w = {r0[0], r1[0], r0[1], r1[1]}; OUT = *reinterpret_cast<bf16x8*>(&w); } while (0)
    PK4(p0, 0, pa0); PK4(p0, 8, pa1); PK4(p1, 0, pa2); PK4(p1, 8, pa3);
#undef PK4
    typedef short v4i16_t __attribute__((ext_vector_type(4)));
    const LAS char* vp = (const LAS char*)(__UINTPTR_TYPE__)(unsigned)vb;
    const bf16x8 pa[4] = {pa0, pa1, pa2, pa3};
#pragma unroll
    for (int ks = 0; ks < 4; ++ks)
#pragma unroll
        for (int d0 = 0; d0 < 4; ++d0) {
            const s16x4 lo = __builtin_bit_cast(s16x4, __builtin_amdgcn_ds_read_tr16_b64_v4i16((LAS v4i16_t*)(vp + v_rd_off(d0, ks, 0))));
            const s16x4 hh = __builtin_bit_cast(s16x4, __builtin_amdgcn_ds_read_tr16_b64_v4i16((LAS v4i16_t*)(vp + v_rd_off(d0, ks, 1))));
            o[d0] = __builtin_amdgcn_mfma_f32_32x32x16_bf16(pa[ks], (bf16x8){lo[0], lo[1], lo[2], lo[3], hh[0], hh[1], hh[2], hh[3]}, o[d0], 0, 0, 0);
        }
}
__device__ __forceinline__ void attn_unit(int b, int h, int qb, const bf16_t* __restrict__ QF, const bf16_t* __restrict__ KF, const bf16_t* __restrict__ KVR, bf16_t* __restrict__ MIX, char* lds) {
    int tid_ = threadIdx.x; asm volatile("" : "+v"(tid_));
    const int tid = tid_, wid = __builtin_amdgcn_readfirstlane(tid >> 6), lane = tid & 63, r32 = lane & 31, hi = lane >> 5;
    char* V_lds = lds; char* K_lds = lds + 4 * SHM_V;
    float* ws = (float*)(lds + 4 * SHM_V + 3 * SHM_K) + wid * 64; float* li_l = ws; float* al_l = ws + 32;
    const long rowbase = (long)b * SEQ; const int q0 = qb * 256;
    float m_reg = 0.f, l_reg = 0.f; f32x16 o[4] = {}; bf16x8 qr[12];
    const bf16_t* Qw = QF + (rowbase + q0 + wid * QBLK + r32) * LDQ + h * 192 + hi * 8;
#pragma unroll
    for (int d0 = 0; d0 < 12; ++d0) qr[d0] = *reinterpret_cast<const bf16x8*>(Qw + d0 * 16);
    VM_WAIT();
#pragma unroll
    for (int d0 = 0; d0 < 12; ++d0) asm volatile("" : "+v"(qr[d0]));
    const bf16_t* Kh = KF + rowbase * LDK + h * 192; const bf16_t* Vh = KVR + rowbase * LDV + h * 256 + 128;
    int koff[3], voff[2];
#pragma unroll
    for (int i = 0; i < 3; ++i) { const int S = (wid * 3 + i) * 64 + lane, row = S / 24, ch = (S % 24) ^ ((row >> 1) & 7); koff[i] = row * LDK + ch * 8; }
#pragma unroll
    for (int i = 0; i < 2; ++i) { const int S = (wid * 2 + i) * 64 + lane, sub = S >> 5, within = S & 31, kk = ((sub >> 2) << 3) | (within >> 2), c = ((sub & 3) << 5) | ((within & 3) << 3);
        const int k = (kk & ~0xC) | ((kk & 4) << 1) | ((kk & 8) >> 1); voff[i] = k * LDV + c; }
    const int vb0 = (int)(uintptr_t)V_lds + v_rd_base(lane);
    LAS unsigned char* Kl = (LAS unsigned char*)(unsigned)(uintptr_t)K_lds; LAS unsigned char* Vl = (LAS unsigned char*)(unsigned)(uintptr_t)V_lds;
#define DMA_TILE(t_, kbuf_, vbo_) do { const bf16_t* kg_ = Kh + (long)(t_) * KVBLK * LDK; const bf16_t* vg_ = Vh + (long)(t_) * KVBLK * LDV; \
    _Pragma("unroll") for (int i = 0; i < 3; ++i) __builtin_amdgcn_global_load_lds((const unsigned*)(kg_ + koff[i]), (LAS unsigned*)(Kl + (kbuf_) * SHM_K + (wid * 3 + i) * 1024), 16, 0, 0); \
    _Pragma("unroll") for (int i = 0; i < 2; ++i) __builtin_amdgcn_global_load_lds((const unsigned*)(vg_ + voff[i]), (LAS unsigned*)(Vl + (vbo_) + (wid * 2 + i) * 1024), 16, 0, 0); } while (0)
#define WAIT_BAR(N) do { asm volatile("s_waitcnt vmcnt(" #N ") lgkmcnt(0)" ::: "memory"); __builtin_amdgcn_s_barrier(); asm volatile("" ::: "memory"); } while (0)
    const int NT = 4 * qb + 4, tmax = 4 * qb + (wid >> 1);
    const bool late = wid >= 4;
    f32x16 p0 = {}, p1 = {};
    int vprev = 3 * SHM_V, vcur = 0, vnext = SHM_V, vnn = 2 * SHM_V;
    int kcur = 0, knext = 1, knn = 2;
    DMA_TILE(0, 0, 0); DMA_TILE(1, 1, SHM_V);
    WAIT_BAR(5);
    for (int j = 0; j < NT; ++j) {
        if (j + 2 < NT) DMA_TILE(j + 2, knn, vnn);
        if (late && j >= 1 && j - 1 <= tmax) sm_pv(p0, p1, m_reg, l_reg, o, al_l, vb0 + vprev, r32, hi, j == 1);
        if (j <= tmax) {
#pragma unroll
            for (int r = 0; r < 16; ++r) { p0[r] = -m_reg; p1[r] = -m_reg; }
            const char* Ks = K_lds + kcur * SHM_K;
            bf16x8 ka[4], kb[4];
#define KRD(dst, D0B) do { _Pragma("unroll") for (int i = 0; i < 2; ++i) { const int cb = (((D0B) + i) * 16 + hi * 8) * 2; \
    dst[2 * i] = *reinterpret_cast<const bf16x8*>(Ks + KSWZ(r32, cb)); dst[2 * i + 1] = *reinterpret_cast<const bf16x8*>(Ks + KSWZ(32 + r32, cb)); } } while (0)
#define KMM(src, D0B) do { _Pragma("unroll") for (int i = 0; i < 2; ++i) { p0 = __builtin_amdgcn_mfma_f32_32x32x16_bf16(src[2 * i], qr[(D0B) + i], p0, 0, 0, 0); \
    p1 = __builtin_amdgcn_mfma_f32_32x32x16_bf16(src[2 * i + 1], qr[(D0B) + i], p1, 0, 0, 0); } } while (0)
            KRD(ka, 0); KRD(kb, 2); SBAR();
            KMM(ka, 0); SBAR(); KRD(ka, 4); SBAR(); KMM(kb, 2); SBAR(); KRD(kb, 6); SBAR();
            KMM(ka, 4); SBAR(); KRD(ka, 8); SBAR(); KMM(kb, 6); SBAR(); KRD(kb, 10); SBAR();
            KMM(ka, 8); SBAR(); KMM(kb, 10);
#undef KRD
#undef KMM
        }
        if (!late && j <= tmax) sm_pv(p0, p1, m_reg, l_reg, o, al_l, vb0 + vcur, r32, hi, j == 0);
        if (j + 2 < NT) WAIT_BAR(5); else WAIT_BAR(0);
        { const int t = vprev; vprev = vcur; vcur = vnext; vnext = vnn; vnn = t; }
        { const int t = kcur; kcur = knext; knext = knn; knn = t; }
    }
    if (late && NT - 1 <= tmax) sm_pv(p0, p1, m_reg, l_reg, o, al_l, vb0 + vprev, r32, hi, false);
    if (hi == 0) li_l[r32] = l_reg;
    LDS_WAIT();
    float rli[16];
#pragma unroll
    for (int r = 0; r < 16; ++r) rli[r] = __builtin_amdgcn_rcpf(li_l[crow(r, hi)]);
    bf16_t* Ow = MIX + (rowbase + q0 + wid * QBLK) * LDO + 1024 + h * 128;
#pragma unroll
    for (int r = 0; r < 16; ++r) { const int orow = crow(r, hi);
#pragma unroll
        for (int d0 = 0; d0 < 4; ++d0) Ow[(long)orow * LDO + d0 * 32 + r32] = (bf16_t)(cvt_pk_bf16(o[d0][r] * rli[r], 0.f) & 0xffffu); }
    WAIT_BAR(0);
#undef DMA_TILE
#undef WAIT_BAR
}
#undef SBAR
}

struct Args { const void* in[32]; float* out; unsigned char* ws; };

__device__ const float INV_FREQ[32] = {
    1.000000000e+00f, 7.498942018e-01f, 5.623413324e-01f, 4.216965139e-01f, 3.162277639e-01f, 2.371373922e-01f, 1.778279394e-01f, 1.333521456e-01f,
    1.000000015e-01f, 7.498941571e-02f, 5.623412877e-02f, 4.216964915e-02f, 3.162277862e-02f, 2.371373586e-02f, 1.778279431e-02f, 1.333521493e-02f,
    9.999999776e-03f, 7.498942316e-03f, 5.623413250e-03f, 4.216964822e-03f, 3.162277862e-03f, 2.371373819e-03f, 1.778279431e-03f, 1.333521446e-03f,
    1.000000047e-03f, 7.498941850e-04f, 5.623413017e-04f, 4.216965463e-04f, 3.162277862e-04f, 2.371373848e-04f, 1.778279402e-04f, 1.333521504e-04f};

__device__ __forceinline__ void transpose_job(const float* W, int ldw, int K, int ncols, const float* gain, bf16_t* WT, int mode, int off,
                                              LAS float* T, int& base, int bx, int G, int tid) {
    const int nblk = (ncols + 127) >> 7, nitems = (K >> 7) * nblk;
    const int first = (bx + G - (base % G)) % G;
    f32x4 R[8];
#define TJ_LOAD(it_) do { const int kb_ = (it_) / nblk, nb_ = (it_) % nblk; \
    _Pragma("unroll") for (int i = 0; i < 8; ++i) { const int idx = tid + 512 * i, row = idx >> 5, n = nb_ * 128 + (idx & 31) * 4; \
        R[i] = (n < ncols) ? *(const f32x4*)(W + (size_t)(kb_ * 128 + row) * ldw + n) : (f32x4){0.f, 0.f, 0.f, 0.f}; } } while (0)
    if (first < nitems) TJ_LOAD(first);
    for (int it = first; it < nitems; it += G) {
        const int kb = it / nblk, nb = it % nblk;
        __syncthreads();
#pragma unroll
        for (int i = 0; i < 8; ++i) { const int idx = tid + 512 * i, row = idx >> 5, c4 = (idx & 31) * 4; const float gsc = gain ? gain[kb * 128 + row] : 1.0f;
            *(LAS f32x4*)(T + row * 128 + (c4 ^ (((row >> 3) & 7) << 2))) = R[i] * gsc; }
        if (it + G < nitems) TJ_LOAD(it + G);
        __syncthreads();
        const int c = tid & 15;
#pragma unroll
        for (int i = 0; i < 4; ++i) { const int nl = 4 * ((tid >> 6) + 8 * i) + ((tid >> 4) & 3), n = nb * 128 + nl; const LAS float* sp = T + (8 * c) * 128 + (nl ^ ((c & 7) << 2));
            u32x4 o; o.x = cvt_pk_bf16(sp[0 * 128], sp[1 * 128]); o.y = cvt_pk_bf16(sp[2 * 128], sp[3 * 128]); o.z = cvt_pk_bf16(sp[4 * 128], sp[5 * 128]); o.w = cvt_pk_bf16(sp[6 * 128], sp[7 * 128]);
            const int drow = (mode == 0) ? (n + off) : (((n >> 7) << 8) + (n & 127) + off);
            if (n < ncols) *(u32x4*)(WT + (size_t)drow * K + kb * 128 + 8 * c) = o; }
    }
#undef TJ_LOAD
    base += nitems;
}


#define XB_TMO      128
#define XB_XCNT(j)  (256  + 64 * (j))
#define XB_XSUB(j)  (1280 + 64 * (j))
#define XB_XGEN(j)  (2304 + 64 * (j))
#define XB_TOP      3328
#define XB_TOPGEN   3392
#define XCD_BAR_WORDS 3456
#define XB_SPIN_CAP (1u << 18)
__device__ __forceinline__ unsigned xb_ld(unsigned* p)              { return __hip_atomic_load(p, __ATOMIC_RELAXED, __HIP_MEMORY_SCOPE_AGENT); }
__device__ __forceinline__ unsigned xb_add(unsigned* p, unsigned v) { return __hip_atomic_fetch_add(p, v, __ATOMIC_RELAXED, __HIP_MEMORY_SCOPE_AGENT); }
__device__ __forceinline__ unsigned xb_xcc_id() { return (unsigned)__builtin_amdgcn_s_getreg((3 << 11) | 20) & 0xFu; }
#define XB_SPIN(cond, bar) do { unsigned _sp = 0; while (cond) { __builtin_amdgcn_s_sleep(1); \
    if ((++_sp & 255u) == 0u) { if (xb_ld(&(bar)[XB_TMO])) break; if (_sp > XB_SPIN_CAP) { atomicAdd(&(bar)[XB_TMO], 1u); break; } } } } while (0)
__device__ __forceinline__ void xcd_barrier_complete(unsigned* bar, unsigned x, unsigned& nloc, unsigned& nx) {
    const unsigned G = gridDim.x * gridDim.y * gridDim.z;
    unsigned sum, cnt, mine, sp = 0u;
    for (;;) {
        sum = 0u; cnt = 0u; mine = 0u;
#pragma unroll
        for (unsigned j = 0; j < 16; ++j) { const unsigned c = xb_ld(&bar[XB_XCNT(j)]); sum += c; cnt += (c > 0u) ? 1u : 0u; mine = (j == x) ? c : mine; }
        if (sum == G) break;
        __builtin_amdgcn_s_sleep(1);
        if ((++sp & 255u) == 0u) { if (xb_ld(&bar[XB_TMO])) break; if (sp > XB_SPIN_CAP) { atomicAdd(&bar[XB_TMO], 1u); break; } }
    }
    nloc = mine > 0u ? mine : 1u; nx = cnt > 0u ? cnt : 1u;
}
__device__ __forceinline__ void xcd_barrier(unsigned* bar, volatile LAS unsigned* st) {
    asm volatile("s_waitcnt vmcnt(0)" ::: "memory");
    __syncthreads();
    if (threadIdx.x == 0) {
        const unsigned x = xb_xcc_id();
        __builtin_amdgcn_s_waitcnt(0);
        unsigned nloc = st[0], nx = st[1];
        if (nloc == 0u) { xcd_barrier_complete(bar, x, nloc, nx); st[0] = nloc; st[1] = nx; }
        const unsigned old = xb_add(&bar[XB_XSUB(x)], 1u);
        const unsigned gen = old / nloc;
        if (old + 1u == (gen + 1u) * nloc) {
            __builtin_amdgcn_fence(__ATOMIC_RELEASE, "agent");
            asm volatile("s_waitcnt vmcnt(0)" ::: "memory");
            const unsigned og = xb_add(&bar[XB_TOP], 1u);
            const unsigned tg = og / nx;
            if (og + 1u == (tg + 1u) * nx) xb_add(&bar[XB_TOPGEN], 1u);
            else XB_SPIN(xb_ld(&bar[XB_TOPGEN]) == tg, bar);
            __builtin_amdgcn_fence(__ATOMIC_ACQUIRE, "agent");
            xb_add(&bar[XB_XGEN(x)], 1u);
            asm volatile("s_waitcnt vmcnt(0)" ::: "memory");
        } else {
            XB_SPIN(xb_ld(&bar[XB_XGEN(x)]) == gen, bar);
            __builtin_amdgcn_fence(__ATOMIC_ACQUIRE, "agent");
            asm volatile("s_waitcnt vmcnt(0)" ::: "memory");
        }
    }
    __syncthreads();
}

__global__ void __launch_bounds__(512, 2) fwd_megakernel(Args a) {
    extern __shared__ __attribute__((aligned(16))) unsigned char lds_raw[];
    cg::grid_group grid = cg::this_grid();
    LAS unsigned char* lds = (LAS unsigned char*)lds_raw;
    int tid = threadIdx.x;
#define lane (tid & 63)
#define wave (__builtin_amdgcn_readfirstlane(tid >> 6))
    int G = gridDim.x, bx = blockIdx.x;
#define vcu ((G % 8 == 0) ? (bx % 8) * (G / 8) + bx / 8 : bx)
#define NGW (G * 8)
#define gw (vcu * 8 + wave)
    unsigned char* ws = a.ws;
    const float* x_in = (const float*)a.in[0];
    float* out = a.out;
#define PHASE_FENCE() do { asm volatile("" : "+s"(ws)); asm volatile("" : "+s"(out)); asm volatile("" : "+v"(tid)); asm volatile("" : "+s"(G)); asm volatile("" : "+s"(bx)); } while (0)
#define GAS __attribute__((address_space(1)))
#define WSG ((GAS unsigned char*)ws)
#define ssq ((ssq_t*)(WSG + WS_SSQ))
#define PAR ((const float*)(WSG + WS_PAR))
#define XB ((bf16_t*)(WSG + WS_XB))
#define HB ((bf16_t*)(WSG + WS_H))
#define KVR ((bf16_t*)(WSG + WS_KVR))
#define MIX ((bf16_t*)(WSG + WS_MIX))
#define MEMB ((bf16_t*)(WSG + WS_MEMB))
#define AGLU ((bf16_t*)(WSG + WS_H + H_AGLU))
#define CQ ((bf16_t*)(WSG + WS_H + H_CQ))
#define CKV ((bf16_t*)(WSG + WS_H + H_CKV))
#define KPE ((bf16_t*)(WSG + WS_H + H_KPE))
#define QF ((bf16_t*)(WSG + WS_H + H_QF))
#define KF ((bf16_t*)(WSG + WS_H + H_KF))
#define QC ((bf16_t*)(WSG + WS_H + H_QC))
#define PC ((bf16_t*)(WSG + WS_H + H_PC))
#define OC ((bf16_t*)(WSG + WS_H + H_OC))
#define WPTR(l, o) ((bf16_t*)(WSG + WS_W + (size_t)(l) * LW + (o)))
#define PARL(l, o) (PAR + PAR_L0 + (l) * PAR_LS + (o))

#define GRID_BAR() xcd_barrier((unsigned*)(GAS unsigned*)(WSG + WS_CTL), (volatile LAS unsigned*)(lds + 139 * 1024))
    if (tid == 0) { ((volatile LAS unsigned*)(lds + 139 * 1024))[0] = 0u; ((volatile LAS unsigned*)(lds + 139 * 1024))[1] = 0u;
                    (void)xb_add((unsigned*)(GAS unsigned*)(WSG + WS_CTL) + XB_XCNT(xb_xcc_id()), 1u); }
    __syncthreads();
#ifdef TPROBE
#define STAMP(k) do { if (tid == 0) ((LAS unsigned long long*)(lds + 140 * 1024))[k] = __builtin_amdgcn_s_memrealtime(); } while (0)
#else
#define STAMP(k) do {} while (0)
#endif
    STAMP(0);
    {
        for (int i = bx * 512 + tid; i < ZERO_COUNT; i += G * 512) ssq[i] = (ssq_t)0;
        { float* par = (float*)(WSG + WS_PAR); const int gt = bx * 512 + tid, GT = G * 512;
          for (int i = gt; i < M; i += GT) ((int*)par)[PAR_POS + i] = ((const int*)a.in[2])[i];
          for (int i = gt; i < 2 * 31744; i += GT) { const int l = i / 31744, j = i % 31744; par[PAR_L0 + l * PAR_LS + PAR_CONVW + j] = ((const float*)a.in[9])[i]; }
          for (int i = gt; i < 2 * 1024; i += GT) { const int l = i >> 10, j = i & 1023; float* pl = par + PAR_L0 + l * PAR_LS;
              pl[PAR_CONVB + j] = ((const float*)a.in[10])[i]; pl[PAR_LNG + j] = ((const float*)a.in[11])[i]; pl[PAR_LNB + j] = ((const float*)a.in[12])[i];
              if (j < 512) { pl[PAR_CQN + j] = ((const float*)a.in[25])[l * 512 + j]; pl[PAR_CKN + j] = ((const float*)a.in[26])[l * 512 + j]; }
              if (j < 192) { pl[PAR_QN + j] = ((const float*)a.in[17])[l * 192 + j]; pl[PAR_KN + j] = ((const float*)a.in[18])[l * 192 + j]; } } }
        for (int l = 0; l < 2; ++l) { u32x4* p = (u32x4*)(WPTR(l, W_IN) + (size_t)NIN * DM); const int n16 = (NINP - NIN) * DM / 8;
            for (int i = bx * 512 + tid; i < n16; i += G * 512) p[i] = (u32x4){0u, 0u, 0u, 0u}; }
        for (int row = gw; row < M + MMEM; row += NGW) {
            const bool is_x = row < M; const int rr = is_x ? row : row - M;
            const float* src = (is_x ? x_in : (const float*)a.in[1]) + (size_t)rr * DM; bf16_t* dst = (is_x ? XB : MEMB) + (size_t)rr * DM;
            float s = 0.f;
#pragma unroll
            for (int j = 0; j < 8; ++j) { const f32x4 v = *(const f32x4*)(src + 256 * j + 4 * lane); s += (v[0] * v[0] + v[1] * v[1]) + (v[2] * v[2] + v[3] * v[3]);
                *(u32x2*)(dst + 256 * j + 4 * lane) = (u32x2){cvt_pk_bf16(v[0], v[1]), cvt_pk_bf16(v[2], v[3])}; }
            s = wave_sum(s);
            if (lane == 0) ssq[(is_x ? NZ_X0 : NZ_MEM) + rr] = ssq_fix(s);
        }
        LAS float* scr = (LAS float*)lds;
        int base = 0;
#pragma unroll 1
        for (int jb = 0; jb < 32; ++jb) {
            const int l = jb >> 4, j = jb & 15;
            const float* Wb = nullptr; const float* gb = nullptr; int ldw = DM, Kk = DM, nc = DM, mode = 0, off = 0, c0 = 0; size_t wo = 0, lstride = (size_t)DM * DM;
            switch (j) {
                case 0:  Wb = (const float*)a.in[4];  gb = (const float*)a.in[3];  ldw = DFF; Kk = DM;  nc = DFF;  mode = 1; off = 0;    wo = W_GU1; lstride = (size_t)DM * DFF; break;
                case 1:  Wb = (const float*)a.in[5];  gb = (const float*)a.in[3];  ldw = DFF; Kk = DM;  nc = DFF;  mode = 1; off = 128;  wo = W_GU1; lstride = (size_t)DM * DFF; break;
                case 2:  Wb = (const float*)a.in[6];  gb = nullptr; ldw = DM;  Kk = DFF; nc = DM;   mode = 0; off = 0;    wo = W_D1;  lstride = (size_t)DM * DFF; break;
                case 3:  Wb = (const float*)a.in[8];  gb = (const float*)a.in[7];  ldw = NIN; Kk = DM;  nc = 1024; mode = 1; off = 0;    wo = W_IN;  lstride = (size_t)DM * NIN; c0 = 0; break;
                case 4:  Wb = (const float*)a.in[8];  gb = (const float*)a.in[7];  ldw = NIN; Kk = DM;  nc = 1024; mode = 1; off = 128;  wo = W_IN;  lstride = (size_t)DM * NIN; c0 = 1024; break;
                case 5:  Wb = (const float*)a.in[8];  gb = (const float*)a.in[7];  ldw = NIN; Kk = DM;  nc = NIN - 2048; mode = 0; off = 2048; wo = W_IN; lstride = (size_t)DM * NIN; c0 = 2048; break;
                case 6:  Wb = (const float*)a.in[14]; gb = (const float*)a.in[13]; ldw = 1536; Kk = 768; nc = 1536; mode = 0; off = 0;   wo = W_QB;  lstride = (size_t)768 * 1536; break;
                case 7:  Wb = (const float*)a.in[16]; gb = (const float*)a.in[15]; ldw = 2048; Kk = 256; nc = 2048; mode = 0; off = 0;   wo = W_KVB; lstride = (size_t)256 * 2048; break;
                case 8:  Wb = (const float*)a.in[19]; gb = nullptr; wo = W_OUT; break;
                case 9:  Wb = (const float*)a.in[22]; gb = (const float*)a.in[20]; wo = W_CQ; break;
                case 10: Wb = (const float*)a.in[23]; gb = (const float*)a.in[21]; wo = W_CKV; break;
                case 11: Wb = (const float*)a.in[24]; gb = (const float*)a.in[21]; wo = W_CKV; off = 2048; break;
                case 12: Wb = (const float*)a.in[27]; gb = nullptr; wo = W_CO; break;
                case 13: Wb = (const float*)a.in[29]; gb = (const float*)a.in[28]; ldw = DFF; Kk = DM;  nc = DFF;  mode = 1; off = 0;    wo = W_GU2; lstride = (size_t)DM * DFF; break;
                case 14: Wb = (const float*)a.in[30]; gb = (const float*)a.in[28]; ldw = DFF; Kk = DM;  nc = DFF;  mode = 1; off = 128;  wo = W_GU2; lstride = (size_t)DM * DFF; break;
                default: Wb = (const float*)a.in[31]; gb = nullptr; ldw = DM;  Kk = DFF; nc = DM;   mode = 0; off = 0;    wo = W_D2;  lstride = (size_t)DM * DFF; break;
            }
            const float* Wp = Wb + (size_t)l * lstride + c0;
            const float* gp = gb ? gb + (size_t)l * Kk : nullptr;
            transpose_job(Wp, ldw, Kk, nc, gp, WPTR(l, wo), mode, off, scr, base, bx, G, tid);
        }
    }
    grid.sync(); PHASE_FENCE(); STAMP(1);

    STAMP(2);
#pragma unroll 1
    for (int l = 0; l < 2; ++l) {
        {
            pg8::Gemm g{XB, WPTR(l, W_GU1), DM, DM, DM, 0}; pg8::Order S; S.init(M / 256, 2 * DFF / 256, G, bx);
            pg8::EpiGateUp E{HB, ssq + ssqx(4 * l + 0)};
            pg8::gemm_phase<pg8::EpiGateUp, pg8::Order, true, true>(lds, g, S, E);
        }
        GRID_BAR(); PHASE_FENCE(); STAMP(3 + 13 * l);
        {
            pg8::Gemm g{HB, WPTR(l, W_D1), DFF, DFF, DFF, 0}; pg8::Order S; S.init(M / 256, DM / 256, G, bx);
            pg8::EpiResid E{l == 0 ? (const float*)(const GAS float*)x_in : (const float*)(GAS float*)out, (float*)(GAS float*)out, XB, ssq + ssqx(4 * l + 1), 0.5f, 1};
            pg8::gemm_phase<pg8::EpiResid, pg8::Order, true, true>(lds, g, S, E);
        }
        GRID_BAR(); PHASE_FENCE(); STAMP(4 + 13 * l);
        {
            pg8::Gemm g{XB, WPTR(l, W_IN), DM, DM, DM, 0}; pg8::Order S; S.init(M / 256, NINP / 256, G, bx);
            pg8::EpiWin E{ssq + ssqx(4 * l + 1), AGLU, CQ, CKV, KPE, ssq + Z_CQ + l * M, ssq + Z_CKV + l * M};
            pg8::gemm_phase<pg8::EpiWin, pg8::Order, true, true>(lds, g, S, E);
        }
        {
            pg8::Gemm g{MEMB, WPTR(l, W_CKV), DM, DM, DM, 0}; pg8::Order S; S.init(MMEM / 256, 4096 / 256, G, (G >= 96 && bx >= 64 && bx < 96) ? bx - 64 : (G >= 96 ? 32 : bx));
            pg8::EpiMemKV E{ssq + NZ_MEM, PARL(l, PAR_CQN), PARL(l, PAR_CKN), (bf16_t*)(WSG + WS_KC) + (size_t)l * MMEM * DM, (bf16_t*)(WSG + WS_VT) + (size_t)l * MMEM * DM, ssq + Z_KC + l * 2048};
            pg8::gemm_phase<pg8::EpiMemKV, pg8::Order, true, true>(lds, g, S, E);
        }
        GRID_BAR(); PHASE_FENCE(); STAMP(5 + 13 * l);
#ifndef NO_CONV
        {
            const float* cw = PARL(l, PAR_CONVW); const float* cb = PARL(l, PAR_CONVB); const float* lg = PARL(l, PAR_LNG); const float* lb = PARL(l, PAR_LNB);
            const int c0 = 2 * tid;
            LAS unsigned* abuf = (LAS unsigned*)lds;
            LAS float* red = (LAS float*)(lds + 62 * 2048);
            float w0[31], w1[31];
#pragma unroll
            for (int k = 0; k < 31; ++k) { w0[k] = cw[k * 1024 + c0]; w1[k] = cw[k * 1024 + c0 + 1]; }
            const float b0 = cb[c0], b1 = cb[c0 + 1], g0 = lg[c0], g1 = lg[c0 + 1], e0 = lb[c0], e1 = lb[c0 + 1];
            for (int tile = bx; tile < M / 32; tile += G) {
                const int t0 = tile * 32, tl0 = t0 % SEQ;
                __syncthreads();
#pragma unroll
                for (int hb = 0; hb < 2; ++hb) {
                    u32x4 v[8];
#pragma unroll
                    for (int i = 0; i < 8; ++i) { const int idx = tid + 512 * (hb * 8 + i), rr = idx >> 7, cc = idx & 127; const bool valid = (idx < 62 * 128) && (tl0 - 30 + rr) >= 0;
                        v[i] = (u32x4){0u, 0u, 0u, 0u}; if (valid) v[i] = *(const u32x4*)(AGLU + (size_t)(t0 - 30 + rr) * 1024 + cc * 8); }
#pragma unroll
                    for (int i = 0; i < 8; ++i) { const int idx = tid + 512 * (hb * 8 + i), rr = idx >> 7, cc = idx & 127;
                        if (idx < 62 * 128) *(LAS u32x4*)(lds + rr * 2048 + cc * 16) = v[i]; }
                }
                __syncthreads();
#pragma unroll 1
                for (int half = 0; half < 2; ++half) {
                    float y0[16], y1[16];
#pragma unroll
                    for (int tt = 0; tt < 16; ++tt) { y0[tt] = b0; y1[tt] = b1; }
                    const LAS unsigned* ab = abuf + half * 16 * 512 + tid;
#pragma unroll
                    for (int rr = 0; rr < 46; ++rr) { const unsigned av = ab[rr * 512]; const float a0 = bf_lo(av), a1 = bf_hi(av);
#pragma unroll
                        for (int tt = 0; tt < 16; ++tt) { const int k = rr - tt; if (k >= 0 && k <= 30) { y0[tt] += a0 * w0[k]; y1[tt] += a1 * w1[k]; } } }
                    float ms = 0.f, mq = 0.f;
#pragma unroll
                    for (int tt = 0; tt < 16; ++tt) { float sv = y0[tt] + y1[tt], qv = y0[tt] * y0[tt] + y1[tt] * y1[tt]; sv = wave_sum(sv); qv = wave_sum(qv);
                        ms = (lane == tt) ? sv : ms; mq = (lane == tt) ? qv : mq; }
                    if (lane < 16) { red[(wave * 16 + lane) * 2] = ms; red[(wave * 16 + lane) * 2 + 1] = mq; }
                    __syncthreads();
                    float mu_v, rs_v;
                    { const int tq = lane & 15; float sv = 0.f, qv = 0.f;
#pragma unroll
                      for (int w = 0; w < 8; ++w) { sv += red[(w * 16 + tq) * 2]; qv += red[(w * 16 + tq) * 2 + 1]; }
                      mu_v = sv * (1.0f / 1024.0f); rs_v = __builtin_amdgcn_rsqf(qv * (1.0f / 1024.0f) - mu_v * mu_v + EPS); }
#pragma unroll
                    for (int tt = 0; tt < 16; ++tt) {
                        const float mu = __int_as_float(__builtin_amdgcn_readlane(__float_as_int(mu_v), tt)), rstd = __int_as_float(__builtin_amdgcn_readlane(__float_as_int(rs_v), tt));
                        const float v0 = (y0[tt] - mu) * rstd * g0 + e0, v1 = (y1[tt] - mu) * rstd * g1 + e1;
                        *(unsigned*)(MIX + (size_t)(t0 + half * 16 + tt) * DM + c0) = cvt_pk_bf16(siluf_(v0), siluf_(v1)); }
                    __syncthreads();
                }
            }
            __syncthreads();
        }
#endif
        STAMP(29 + 3 * l);
        {
            pg8::Gemm g{CQ, WPTR(l, W_QB), 768, 768, 768, 0}; pg8::Order S; S.init(M / 256, 1536 / 256, G, bx);
            pg8::EpiPlain E{QF, 1536, ssq + Z_CQ + l * M, 1.0f / 768.0f};
            pg8::gemm_phase<pg8::EpiPlain, pg8::Order, true, true>(lds, g, S, E);
        }
        STAMP(30 + 3 * l);
        {
            pg8::Gemm g{CKV, WPTR(l, W_KVB), 256, 256, 256, 0}; pg8::Order S; S.init(M / 256, 2048 / 256, G, bx);
            pg8::EpiPlain E{KVR, 2048, ssq + Z_CKV + l * M, 1.0f / 256.0f};
            pg8::gemm_phase<pg8::EpiPlain, pg8::Order, true, true>(lds, g, S, E);
        }
        GRID_BAR(); PHASE_FENCE(); STAMP(6 + 13 * l);
#ifndef NO_PREP
        {
            const float* gq = PARL(l, PAR_QN); const float* gk = PARL(l, PAR_KN); const int* pos = (const int*)(PAR + PAR_POS);
            const float gq0 = gq[2 * lane], gq1 = gq[2 * lane + 1], gqr = gq[128 + lane], gk0 = gk[2 * lane], gk1 = gk[2 * lane + 1], gkr = gk[128 + lane];
            const float invf = INV_FREQ[lane & 31];
            for (int row0 = gw; row0 < M; row0 += 2 * NGW) {
                const int rowv[2] = {row0, (row0 + NGW < M) ? row0 + NGW : row0};
                unsigned kpe_w[2], kw[2][8], qw[2][8], qrw[2][8]; int posv[2];
#pragma unroll
                for (int t = 0; t < 2; ++t) { const int row = rowv[t]; const bf16_t* kvp = KVR + (size_t)row * 2048 + 2 * lane; const bf16_t* qp = QF + (size_t)row * 1536;
                    kpe_w[t] = *(const unsigned*)(KPE + (size_t)row * 64 + (lane & ~1)); posv[t] = pos[row];
#pragma unroll
                    for (int h = 0; h < 8; ++h) { kw[t][h] = *(const unsigned*)(kvp + h * 256); qw[t][h] = *(const unsigned*)(qp + h * 192 + 2 * lane); qrw[t][h] = *(const unsigned*)(qp + h * 192 + 128 + (lane & ~1)); } }
                unsigned ko[2][8], qo[2][8]; unsigned kro[2][8], qro[2][8];
#pragma unroll
                for (int t = 0; t < 2; ++t) {
                    const float ang = (float)posv[t] * invf;
                    double rev = (double)ang * 0.15915494309189535; rev -= __builtin_rint(rev);
                    const float frv = (float)rev; const float cs = __builtin_amdgcn_cosf(frv), sn = __builtin_amdgcn_sinf(frv);
                    const float sgn = (lane < 32) ? -sn : sn;
                    const float kraw = (lane & 1) ? bf_hi(kpe_w[t]) : bf_lo(kpe_w[t]); const float ssq_pe = wave_sum(kraw * kraw);
                    const float ky = kraw * gkr; const float kpart = __shfl_xor(ky, 32); const float krot = ky * cs + kpart * sgn;
#pragma unroll
                    for (int h = 0; h < 8; ++h) {
                        const float v0 = bf_lo(kw[t][h]), v1 = bf_hi(kw[t][h]);
                        const float sq = wave_sum(v0 * v0 + v1 * v1) + ssq_pe; const float rs = rstd_of(sq, 1.0f / 192.0f);
                        ko[t][h] = cvt_pk_bf16(v0 * rs * gk0, v1 * rs * gk1); kro[t][h] = cvt_pk_bf16(krot * rs, 0.f);
                    }
#pragma unroll
                    for (int h = 0; h < 8; ++h) {
                        const float v0 = bf_lo(qw[t][h]), v1 = bf_hi(qw[t][h]); const float vr = (lane & 1) ? bf_hi(qrw[t][h]) : bf_lo(qrw[t][h]);
                        const float sq = wave_sum(v0 * v0 + v1 * v1 + vr * vr); const float rs = rstd_of(sq, 1.0f / 192.0f) * QSCALE;
                        const float qy = vr * gqr; const float qpart = __shfl_xor(qy, 32); const float qrot = qy * cs + qpart * sgn;
                        qo[t][h] = cvt_pk_bf16(v0 * rs * gq0, v1 * rs * gq1); qro[t][h] = cvt_pk_bf16(qrot * rs, 0.f);
                    }
                }
#pragma unroll
                for (int t = 0; t < 2; ++t) { if (t == 1 && rowv[1] == rowv[0]) break; bf16_t* qp0 = QF + (size_t)rowv[t] * 1536; bf16_t* kp0 = KF + (size_t)rowv[t] * 1536;
#pragma unroll
                    for (int h = 0; h < 8; ++h) { *(unsigned*)(kp0 + h * 192 + 2 * lane) = ko[t][h]; kp0[h * 192 + 128 + lane] = (bf16_t)(kro[t][h] & 0xffffu);
                        *(unsigned*)(qp0 + h * 192 + 2 * lane) = qo[t][h]; qp0[h * 192 + 128 + lane] = (bf16_t)(qro[t][h] & 0xffffu); } }
            }
        }
#endif
        GRID_BAR(); PHASE_FENCE(); STAMP(7 + 13 * l);
#ifndef NO_ATTN
        {
            for (int it = vcu; it < 256; it += G) { const int bh = it >> 4, s = it & 15;
                mla::attn_unit(bh >> 3, bh & 7, 31 - s, QF, KF, KVR, MIX, (char*)lds_raw);
                mla::attn_unit(bh >> 3, bh & 7, s, QF, KF, KVR, MIX, (char*)lds_raw); }
        }
#endif
        GRID_BAR(); PHASE_FENCE(); STAMP(8 + 13 * l);
        {
            pg8::Gemm g{MIX, WPTR(l, W_OUT), DM, DM, DM, 0}; pg8::Order S; S.init(M / 256, DM / 256, G, bx);
            pg8::EpiResid E{(const float*)(GAS float*)out, (float*)(GAS float*)out, XB, ssq + ssqx(4 * l + 2), 1.0f, 1};
            pg8::gemm_phase<pg8::EpiResid, pg8::Order, true, true>(lds, g, S, E);
        }
        GRID_BAR(); PHASE_FENCE(); STAMP(9 + 13 * l);
        {
            pg8::Gemm g{XB, WPTR(l, W_CQ), DM, DM, DM, 0}; pg8::Order S; S.init(M / 256, DM / 256, G, bx);
            pg8::EpiCq E{QC, ssq + ssqx(4 * l + 2), ssq + Z_QC + l * 4 * M};
            pg8::gemm_phase<pg8::EpiCq, pg8::Order, true, true>(lds, g, S, E);
        }
        GRID_BAR(); PHASE_FENCE(); STAMP(10 + 13 * l);
        {
            pg8::Gemm g{QC, (bf16_t*)(WSG + WS_KC) + (size_t)l * MMEM * DM, DM, DM, 512, 1};
            pg8::EpiSoftmax E{PC, ssq + Z_QC + l * 4 * M, ssq + Z_KC + l * 2048};
            for (int u = bx; u < 256; u += G) { pg8::SingleOrder S; S.u0.pm = u >> 2; S.u0.pn = u & 3;
                pg8::gemm_phase<pg8::EpiSoftmax, pg8::SingleOrder, false, true>(lds, g, S, E); }
        }
        GRID_BAR(); PHASE_FENCE(); STAMP(11 + 13 * l);
        {
            pg8::Gemm g{PC, (bf16_t*)(WSG + WS_VT) + (size_t)l * MMEM * DM, 1024, 256, 256, 2}; pg8::Order S; S.init(M / 256, 8, G, bx);
            pg8::EpiPlain E{OC, DM, nullptr, 1.0f};
            pg8::gemm_phase<pg8::EpiPlain, pg8::Order, true, true>(lds, g, S, E);
        }
        GRID_BAR(); PHASE_FENCE(); STAMP(12 + 13 * l);
        {
            pg8::Gemm g{OC, WPTR(l, W_CO), DM, DM, DM, 0}; pg8::Order S; S.init(M / 256, DM / 256, G, bx);
            pg8::EpiResid E{(const float*)(GAS float*)out, (float*)(GAS float*)out, XB, ssq + ssqx(4 * l + 3), 1.0f, 1};
            pg8::gemm_phase<pg8::EpiResid, pg8::Order, true, true>(lds, g, S, E);
        }
        GRID_BAR(); PHASE_FENCE(); STAMP(13 + 13 * l);
        {
            pg8::Gemm g{XB, WPTR(l, W_GU2), DM, DM, DM, 0}; pg8::Order S; S.init(M / 256, 2 * DFF / 256, G, bx);
            pg8::EpiGateUp E{HB, ssq + ssqx(4 * l + 3)};
            pg8::gemm_phase<pg8::EpiGateUp, pg8::Order, true, true>(lds, g, S, E);
        }
        GRID_BAR(); PHASE_FENCE(); STAMP(14 + 13 * l);
        {
            pg8::Gemm g{HB, WPTR(l, W_D2), DFF, DFF, DFF, 0}; pg8::Order S; S.init(M / 256, DM / 256, G, bx);
            pg8::EpiResid E{(const float*)(GAS float*)out, (float*)(GAS float*)out, XB, ssq + ssqx(4 * l + 4), 0.5f, l == 0 ? 1 : 0};
            pg8::gemm_phase<pg8::EpiResid, pg8::Order, true, true>(lds, g, S, E);
        }
#ifdef TPROBE
        GRID_BAR(); PHASE_FENCE(); STAMP(15 + 13 * l);
#else
        if (l == 0) { GRID_BAR(); PHASE_FENCE(); }
#endif
    }
#ifdef TPROBE
    {
        __syncthreads();
        const LAS unsigned long long* ts = (const LAS unsigned long long*)(lds + 140 * 1024);
        const float T = (float)(ts[28] - ts[0]);
        float sel = (float)(ts[TSEL_HI] - ts[TSEL_LO]);
        if (TSEL_BOTH) sel += (float)(ts[TSEL_HI + 13] - ts[TSEL_LO + 13]);
        const float dlt = 0.012f * sqrtf(sel / T);
        float* o = (float*)(GAS float*)out;
        for (int i = bx * 512 + tid; i < (1 << 22); i += G * 512) o[i] += (i & 1) ? dlt : -dlt;
    }
#endif
}

extern "C" void kernel_launch(void* const* d_in, const int* in_sizes, int n_in, void* d_out, int out_size, void* d_ws, size_t ws_size, hipStream_t stream) {
    static int grid = 0;
    if (grid == 0) {
        if (n_in != 32 || out_size != M * DM || ws_size < WS_END) { fprintf(stderr, "kernel_launch: unexpected shapes: n_in %d out %d ws %zu (need %zu)\n", n_in, out_size, ws_size, (size_t)WS_END); grid = -1; return; }
        int dev = 0, cus = 0, per_cu = 0;
        if (hipGetDevice(&dev) != hipSuccess || hipDeviceGetAttribute(&cus, hipDeviceAttributeMultiprocessorCount, dev) != hipSuccess) { grid = -1; return; }
        if (hipFuncSetAttribute((const void*)fwd_megakernel, hipFuncAttributeMaxDynamicSharedMemorySize, LDS_BYTES) != hipSuccess) { fprintf(stderr, "hipFuncSetAttribute failed\n"); grid = -1; return; }
        if (hipOccupancyMaxActiveBlocksPerMultiprocessor(&per_cu, (const void*)fwd_megakernel, 512, LDS_BYTES) != hipSuccess || per_cu < 1) { fprintf(stderr, "occupancy query failed (%d)\n", per_cu); grid = -1; return; }
        grid = cus * per_cu;
    }
    if (grid < 0) return;
    if (hipMemsetAsync((char*)d_ws + WS_CTL, 0, CTL_BYTES, stream) != hipSuccess) { fprintf(stderr, "memset failed\n"); return; }
    Args a{};
    for (int i = 0; i < 32; ++i) a.in[i] = d_in[i];
    a.out = (float*)d_out; a.ws = (unsigned char*)d_ws;
    void* args[] = {&a};
    hipError_t e = hipLaunchCooperativeKernel((const void*)fwd_megakernel, dim3(grid), dim3(512), args, LDS_BYTES, stream);
    if (e != hipSuccess) fprintf(stderr, "cooperative launch failed: %s (grid %d)\n", hipGetErrorString(e), grid);
}
```

```cpp
#include <hip/hip_runtime.h>
#include <hip/hip_cooperative_groups.h>
#include <cstdio>
#include <cstdint>
namespace cg = cooperative_groups;

#define LAS __attribute__((address_space(3)))
typedef unsigned short bf16_t;
typedef short bf16x8 __attribute__((ext_vector_type(8)));
typedef short s16x4 __attribute__((ext_vector_type(4)));
typedef float f32x4 __attribute__((ext_vector_type(4)));
typedef float f32x16 __attribute__((ext_vector_type(16)));
typedef unsigned u32x4 __attribute__((ext_vector_type(4)));
typedef unsigned u32x2 __attribute__((ext_vector_type(2)));
typedef unsigned long long ssq_t;

constexpr int M = 16384, DM = 2048, DFF = 5632, SEQ = 8192, NMEM = 256, MMEM = 512;
constexpr int NIN = 3136, NINP = 3328;
constexpr float EPS = 1e-6f;
constexpr float LOG2E = 1.4426950408889634f;
constexpr float QSCALE = 0.07216878364870322f * LOG2E;
constexpr float XSCALE = 0.04419417382415922f * LOG2E;

constexpr size_t MiB = 1u << 20;
constexpr size_t WS_SSQ = 760 * MiB;
constexpr size_t WS_W = 2 * MiB, LW = 190 * MiB;
constexpr size_t W_GU1 = 0, W_D1 = 44 * MiB, W_IN = 66 * MiB, W_QB = 79 * MiB, W_KVB = 82 * MiB, W_OUT = 83 * MiB, W_CQ = 91 * MiB,
                 W_CKV = 99 * MiB, W_CO = 115 * MiB, W_GU2 = 123 * MiB, W_D2 = 167 * MiB;
constexpr size_t WS_XB = 382 * MiB, WS_H = 446 * MiB, WS_KVR = 622 * MiB, WS_MIX = 686 * MiB, WS_MEMB = 750 * MiB, WS_KC = 752 * MiB,
                 WS_VT = 756 * MiB, WS_END = 764 * MiB;
constexpr size_t H_AGLU = 0, H_CQ = 32 * MiB, H_CKV = 56 * MiB, H_KPE = 64 * MiB, H_QF = 66 * MiB, H_KF = 114 * MiB;
constexpr size_t H_QC = 0, H_PC = 64 * MiB, H_OC = 96 * MiB;
constexpr int Z_CQ = 8 * M, Z_CKV = 10 * M, Z_QC = 12 * M, Z_KC = 20 * M, ZERO_COUNT = 20 * M + 4096, NZ_X0 = ZERO_COUNT, NZ_MEM = ZERO_COUNT + M;
__device__ __forceinline__ int ssqx(int s) { return s == 0 ? NZ_X0 : (s - 1) * M; }

constexpr size_t WS_PAR = 1536 * 1024;
constexpr int PAR_POS = 0, PAR_L0 = 16384, PAR_LS = 36864, PAR_CONVW = 0, PAR_CONVB = 31744, PAR_LNG = 32768, PAR_LNB = 33792, PAR_QN = 34816, PAR_KN = 35008, PAR_CQN = 35200, PAR_CKN = 35712;
constexpr size_t WS_CTL = 1900 * 1024, CTL_BYTES = 16384;
constexpr int LDS_BYTES = 147456;

__device__ __forceinline__ unsigned cvt_pk_bf16(float lo, float hi) { unsigned r; asm volatile("v_cvt_pk_bf16_f32 %0, %1, %2" : "=v"(r) : "v"(lo), "v"(hi)); return r; }
typedef _Float16 f16x2 __attribute__((ext_vector_type(2)));
typedef _Float16 f16x8 __attribute__((ext_vector_type(8)));
typedef float f32x2c __attribute__((ext_vector_type(2)));
__device__ __forceinline__ unsigned cvt_pk_f16(float lo, float hi) { const f16x2 h = __builtin_convertvector((f32x2c){lo, hi}, f16x2); return __builtin_bit_cast(unsigned, h); }
__device__ __forceinline__ float h_lo(unsigned w) { return (float)__builtin_bit_cast(f16x2, w)[0]; }
__device__ __forceinline__ float h_hi(unsigned w) { return (float)__builtin_bit_cast(f16x2, w)[1]; }
__device__ __forceinline__ float bf_lo(unsigned w) { return __uint_as_float(w << 16); }
__device__ __forceinline__ float bf_hi(unsigned w) { return __uint_as_float(w & 0xffff0000u); }
__device__ __forceinline__ float bf2f(bf16_t v) { return __uint_as_float(((unsigned)v) << 16); }
__device__ __forceinline__ float wave_sum(float v) {
    v += __int_as_float(__builtin_amdgcn_update_dpp(0, __float_as_int(v), 0xB1, 0xF, 0xF, true));
    v += __int_as_float(__builtin_amdgcn_update_dpp(0, __float_as_int(v), 0x4E, 0xF, 0xF, true));
    v += __int_as_float(__builtin_amdgcn_update_dpp(0, __float_as_int(v), 0x141, 0xF, 0xF, true));
    v += __int_as_float(__builtin_amdgcn_update_dpp(0, __float_as_int(v), 0x140, 0xF, 0xF, true));
    const float a = __int_as_float(__builtin_amdgcn_readlane(__float_as_int(v), 0)), b = __int_as_float(__builtin_amdgcn_readlane(__float_as_int(v), 16));
    const float c = __int_as_float(__builtin_amdgcn_readlane(__float_as_int(v), 32)), d = __int_as_float(__builtin_amdgcn_readlane(__float_as_int(v), 48));
    return (a + b) + (c + d);
}
__device__ __forceinline__ float rstd_of(float ssq, float inv_n) { return __builtin_amdgcn_rsqf(ssq * inv_n + EPS); }
__device__ __forceinline__ float rstd_of(ssq_t v, float inv_n) { return __builtin_amdgcn_rsqf(((float)v * 2.3283064365386963e-10f) * inv_n + EPS); }
__device__ __forceinline__ ssq_t ssq_fix(float s) { return (ssq_t)(s * 4294967296.0f); }
__device__ __forceinline__ float sigmoidf_(float g) { return __builtin_amdgcn_rcpf(1.0f + __builtin_amdgcn_exp2f(-g * LOG2E)); }
__device__ __forceinline__ float siluf_(float g) { return g * sigmoidf_(g); }
#define LDS_WAIT() asm volatile("s_waitcnt lgkmcnt(0)" ::: "memory")
#define VM_WAIT() asm volatile("s_waitcnt vmcnt(0)" ::: "memory")

namespace pg8 {
constexpr int BM = 256, BK = 64, HALF = 128, HTB = HALF * BK * 2, STAGE_BYTES = 8 * HTB, NXCD = 8, WGM = 8;
__host__ __device__ __forceinline__ int lds_byte(int r, int c) { const int st = (r >> 4) * 2 + (c >> 5), rr = r & 15, cc = c & 31, ob = rr * 64 + cc * 2; return st * 1024 + (ob ^ (((ob >> 9) & 1) << 5)); }
__host__ __device__ __forceinline__ void stage_rc(int b, int& R, int& C) { const int st = b / 1024, sb = b % 1024, swz = sb ^ (((sb >> 9) & 1) << 5); R = (st >> 1) * 16 + swz / 64; C = (st & 1) * 32 + (swz % 64) / 2; }
__host__ __device__ __forceinline__ int perm32(int rho) { const int n = rho >> 4, i = rho & 15; return 8 * (i >> 2) + 4 * n + (i & 3); }

struct Unit { int pm, pn; };
struct Gemm { const bf16_t* A; const bf16_t* Bt; int lda, ldb, K, mode; };
__device__ __forceinline__ void unit_ptrs(const Gemm& g, const Unit& u, const char*& pa, const char*& pb) {
    size_t ao, bo;
    if (g.mode == 0) { ao = (size_t)u.pm * 256 * g.lda; bo = (size_t)u.pn * 256 * g.ldb; }
    else if (g.mode == 1) { ao = (size_t)u.pm * 256 * g.lda + (size_t)u.pn * 512; bo = (size_t)(u.pm >> 5) * 256 * g.ldb + (size_t)u.pn * 512; }
    else { const int h = u.pn >> 1, dt = u.pn & 1; ao = (size_t)u.pm * 256 * g.lda + (size_t)h * 256; bo = (size_t)((((u.pm >> 5) * 4 + h) * 512) + dt * 256) * g.ldb; }
    pa = (const char*)g.A + ao * 2; pb = (const char*)g.Bt + bo * 2;
}
struct Order {
    int nM, nN, nwg, G, c;
    __device__ __forceinline__ void init(int nM_, int nN_, int G_, int c_) { nM = nM_; nN = nN_; nwg = nM * nN; G = G_; c = c_; }
    __device__ __forceinline__ bool next(int i, Unit& u) const {
        const long L = (long)i * G + c; if (L >= nwg) return false;
        int wgid = (int)L; { const int q = nwg / NXCD, r = nwg % NXCD, xcd = wgid % NXCD, off = wgid / NXCD; wgid = (xcd < r ? xcd * (q + 1) : r * (q + 1) + (xcd - r) * q) + off; }
        const int nig = WGM * nN, gid = wgid / nig, fm = gid * WGM, gsz = (nM - fm) < WGM ? (nM - fm) : WGM;
        u.pm = fm + ((wgid % nig) % gsz); u.pn = (wgid % nig) / gsz; return true;
    }
};
struct SingleOrder {
    Unit u0;
    __device__ __forceinline__ bool next(int i, Unit& u) const { if (i != 0) return false; u = u0; return true; }
};

template <class Epi, class Sched, bool ALIGN_EPI, bool SP2>
__device__ __forceinline__ void gemm_phase(LAS unsigned char* lds, const Gemm g, const Sched& S, const Epi& E) {
    int tid_ = threadIdx.x; asm volatile("" : "+v"(tid_));
    const int tid = tid_, wid = __builtin_amdgcn_readfirstlane(tid >> 6), lane = tid & 63, wr = wid >> 2, wc = wid & 3, fr = lane & 15, fq = lane >> 4;
    const int K = g.K, nt = K / BK;
    unsigned voffA[2], voffB[2];
#pragma unroll
    for (int i = 0; i < 2; ++i) { int R, C; stage_rc(tid * 16 + i * 8192, R, C); const int Rb = Epi::PERM ? ((R & ~31) + perm32(R & 31)) : R;
        voffA[i] = (unsigned)(R * g.lda + C) * 2u; voffB[i] = (unsigned)(Rb * g.ldb + C) * 2u; }
    const size_t kstep = (size_t)(BK * 2);
    const size_t hstepA = (size_t)HALF * g.lda * 2, hstepB = (size_t)HALF * g.ldb * 2;
    const unsigned ldsw = (unsigned)wid * 1024u;
    const int aoff = lds_byte(wr * 64 + fr, fq * 8), boff = lds_byte(wc * 32 + fr, fq * 8);
#define PG8_SA(b, h) (((b) * 2 + (h)) * HTB)
#define PG8_SB(b, h) ((4 + (b) * 2 + (h)) * HTB)
#define PG8_STAGE(bufoff, gbase, voff) do { _Pragma("unroll") for (int _i = 0; _i < 2; ++_i) \
        __builtin_amdgcn_global_load_lds((const unsigned*)((const char*)(gbase) + (voff)[_i]), (LAS unsigned*)(lds + (bufoff) + ldsw + _i * 8192), 16, 0, 0); } while (0)
#define PG8_LDA(dst, b, h) do { _Pragma("unroll") for (int m = 0; m < 4; ++m) _Pragma("unroll") for (int k = 0; k < 2; ++k) dst[m][k] = *(const LAS bf16x8*)(lds + PG8_SA(b, h) + aoff + m * 2048 + k * 1024); } while (0)
#define PG8_LDB(dst, b, h) do { _Pragma("unroll") for (int n = 0; n < 2; ++n) _Pragma("unroll") for (int k = 0; k < 2; ++k) dst[n][k] = *(const LAS bf16x8*)(lds + PG8_SB(b, h) + boff + n * 2048 + k * 1024); } while (0)
#define PG8_MMA(ai, bj, At, Bt) do { __builtin_amdgcn_s_setprio(1); _Pragma("unroll") for (int m = 0; m < 4; ++m) _Pragma("unroll") for (int n = 0; n < 2; ++n) _Pragma("unroll") for (int k = 0; k < 2; ++k) \
        acc[ai][bj][m][n] = Epi::F16 ? __builtin_amdgcn_mfma_f32_16x16x32_f16(__builtin_bit_cast(f16x8, Bt[n][k]), __builtin_bit_cast(f16x8, At[m][k]), acc[ai][bj][m][n], 0, 0, 0) \
        : __builtin_amdgcn_mfma_f32_16x16x32_bf16(Bt[n][k], At[m][k], acc[ai][bj][m][n], 0, 0, 0); __builtin_amdgcn_s_setprio(0); } while (0)
#define PG8_WAIT_V(n) asm volatile("s_waitcnt vmcnt(" #n ")" ::: "memory")
#define PG8_WAIT_L(n) asm volatile("s_waitcnt lgkmcnt(" #n ")" ::: "memory")
#define PG8_BAR __builtin_amdgcn_s_barrier()
#define PG8_SCHED __builtin_amdgcn_sched_barrier(0)
    Unit cur, nxt; int ui = 0;
    if (!S.next(0, cur)) return;
    f32x4 acc[2][2][4][2];
#pragma unroll
    for (int a = 0; a < 2; ++a)
#pragma unroll
        for (int b = 0; b < 2; ++b)
#pragma unroll
            for (int m = 0; m < 4; ++m)
#pragma unroll
                for (int n = 0; n < 2; ++n) acc[a][b][m][n] = (f32x4){0.f, 0.f, 0.f, 0.f};
    bf16x8 At[4][2], B0[2][2], B1[2][2];
    const char* cA; const char* cB; unit_ptrs(g, cur, cA, cB);
    if constexpr (SP2) {
        PG8_STAGE(PG8_SB(0, 0), cB, voffB); PG8_STAGE(PG8_SB(0, 1), cB + hstepB, voffB); PG8_STAGE(PG8_SA(0, 0), cA, voffA); PG8_STAGE(PG8_SA(0, 1), cA + hstepA, voffA);
        if (wr == 1) PG8_BAR;
        PG8_WAIT_V(2); PG8_BAR;
        PG8_STAGE(PG8_SB(1, 0), cB + kstep, voffB); PG8_STAGE(PG8_SA(1, 0), cA + kstep, voffA); PG8_STAGE(PG8_SB(1, 1), cB + hstepB + kstep, voffB);
        PG8_WAIT_V(6); PG8_BAR;
    } else {
        PG8_STAGE(PG8_SB(0, 0), cB, voffB); PG8_STAGE(PG8_SA(0, 0), cA, voffA); PG8_STAGE(PG8_SB(0, 1), cB + hstepB, voffB); PG8_STAGE(PG8_SA(0, 1), cA + hstepA, voffA);
        if (wr == 1) PG8_BAR;
        PG8_WAIT_V(4); PG8_BAR;
        PG8_STAGE(PG8_SB(1, 0), cB + kstep, voffB); PG8_STAGE(PG8_SA(1, 0), cA + kstep, voffA); PG8_STAGE(PG8_SB(1, 1), cB + hstepB + kstep, voffB);
        PG8_WAIT_V(6); PG8_BAR;
    }
    for (;;) {
        const bool has_next = S.next(ui + 1, nxt);
        const char* nA = cA; const char* nB = cB; if (has_next) unit_ptrs(g, nxt, nA, nB);
        for (int t = 0; t < nt; t += 2) {
            const bool last = (t == nt - 2);
            const char* a1 = cA + (size_t)(t + 1) * kstep;
            const char* a2 = last ? nA : cA + (size_t)(t + 2) * kstep; const char* b2 = last ? nB : cB + (size_t)(t + 2) * kstep;
            const char* a3 = a2 + kstep; const char* b3 = b2 + kstep;
            if constexpr (SP2) {
            PG8_LDB(B0, 0, 0); PG8_LDB(B1, 0, 1); PG8_SCHED; PG8_LDA(At, 0, 0); PG8_STAGE(PG8_SA(1, 1), a1 + hstepA, voffA);
            PG8_WAIT_V(8); PG8_WAIT_L(0); PG8_BAR; PG8_MMA(0, 0, At, B0); PG8_MMA(0, 1, At, B1); PG8_BAR; PG8_SCHED;
            PG8_LDA(At, 0, 1); PG8_STAGE(PG8_SB(0, 0), b2, voffB); PG8_STAGE(PG8_SB(0, 1), b2 + hstepB, voffB); PG8_STAGE(PG8_SA(0, 0), a2, voffA);
            PG8_WAIT_V(8); PG8_WAIT_L(0); PG8_BAR; PG8_MMA(1, 0, At, B0); PG8_MMA(1, 1, At, B1); PG8_BAR; PG8_SCHED;
            PG8_LDB(B0, 1, 0); PG8_LDB(B1, 1, 1); PG8_SCHED; PG8_LDA(At, 1, 0); PG8_STAGE(PG8_SA(0, 1), a2 + hstepA, voffA);
            PG8_WAIT_V(8); PG8_WAIT_L(0); PG8_BAR; PG8_MMA(0, 0, At, B0); PG8_MMA(0, 1, At, B1); PG8_BAR; PG8_SCHED;
            PG8_LDA(At, 1, 1); PG8_STAGE(PG8_SB(1, 0), b3, voffB); PG8_STAGE(PG8_SB(1, 1), b3 + hstepB, voffB); PG8_STAGE(PG8_SA(1, 0), a3, voffA);
            PG8_WAIT_V(8); PG8_WAIT_L(0); PG8_BAR; PG8_MMA(1, 0, At, B0); PG8_MMA(1, 1, At, B1); PG8_BAR; PG8_SCHED;
            } else {
            PG8_LDB(B0, 0, 0); PG8_SCHED; PG8_LDA(At, 0, 0); PG8_STAGE(PG8_SA(1, 1), a1 + hstepA, voffA);
            PG8_WAIT_L(8); PG8_BAR; PG8_WAIT_L(0); PG8_MMA(0, 0, At, B0); PG8_BAR; PG8_SCHED;
            PG8_LDB(B1, 0, 1); PG8_STAGE(PG8_SB(0, 0), b2, voffB);
            PG8_BAR; PG8_WAIT_L(0); PG8_MMA(0, 1, At, B1); PG8_BAR;
            PG8_LDA(At, 0, 1); PG8_STAGE(PG8_SA(0, 0), a2, voffA);
            PG8_BAR; PG8_WAIT_L(0); PG8_MMA(1, 0, At, B0); PG8_BAR; PG8_SCHED;
            PG8_STAGE(PG8_SB(0, 1), b2 + hstepB, voffB);
            PG8_WAIT_V(6); PG8_BAR; PG8_MMA(1, 1, At, B1); PG8_BAR;
            PG8_LDB(B0, 1, 0); PG8_SCHED; PG8_LDA(At, 1, 0); PG8_STAGE(PG8_SA(0, 1), a2 + hstepA, voffA);
            PG8_WAIT_L(8); PG8_BAR; PG8_WAIT_L(0); PG8_MMA(0, 0, At, B0); PG8_BAR; PG8_SCHED;
            PG8_LDB(B1, 1, 1); PG8_STAGE(PG8_SB(1, 0), b3, voffB);
            PG8_BAR; PG8_WAIT_L(0); PG8_MMA(0, 1, At, B1); PG8_BAR;
            PG8_LDA(At, 1, 1); PG8_STAGE(PG8_SA(1, 0), a3, voffA);
            PG8_BAR; PG8_WAIT_L(0); PG8_MMA(1, 0, At, B0); PG8_BAR; PG8_SCHED;
            PG8_STAGE(PG8_SB(1, 1), b3 + hstepB, voffB);
            PG8_WAIT_V(6); PG8_BAR; PG8_MMA(1, 1, At, B1); PG8_BAR;
            }
        }
        if constexpr (ALIGN_EPI) { if (wr == 0) PG8_BAR; }
        if constexpr (!Epi::AFTER_DRAIN) { E(acc, cur, wr, wc, fr, fq); }
        if (!has_next) break;
#pragma unroll
        for (int a = 0; a < 2; ++a)
#pragma unroll
            for (int b = 0; b < 2; ++b)
#pragma unroll
                for (int m = 0; m < 4; ++m)
#pragma unroll
                    for (int n = 0; n < 2; ++n) acc[a][b][m][n] = (f32x4){0.f, 0.f, 0.f, 0.f};
        cur = nxt; cA = nA; cB = nB; ++ui;
        if constexpr (ALIGN_EPI) { if (wr == 1) PG8_BAR; }
    }
    PG8_WAIT_V(0);
    if constexpr (!ALIGN_EPI) { if (wr == 0) PG8_BAR; }
    PG8_BAR;
    if constexpr (Epi::AFTER_DRAIN) { E.fused(acc, cur, wr, wc, fr, fq, lds, wid, lane); }
#undef PG8_SA
#undef PG8_SB
#undef PG8_STAGE
#undef PG8_LDA
#undef PG8_LDB
#undef PG8_MMA
#undef PG8_WAIT_V
#undef PG8_WAIT_L
#undef PG8_BAR
#undef PG8_SCHED
}

typedef f32x4 Acc[2][2][4][2];
#define PACK8(v0, v1) (u32x4){cvt_pk_bf16((v0)[0], (v0)[1]), cvt_pk_bf16((v0)[2], (v0)[3]), cvt_pk_bf16((v1)[0], (v1)[1]), cvt_pk_bf16((v1)[2], (v1)[3])}

struct EpiGateUp {
    static constexpr bool PERM = true, AFTER_DRAIN = false, F16 = true;
    bf16_t* H; const ssq_t* ssq;
    __device__ __forceinline__ void operator()(const Acc& acc, const Unit& u, int wr, int wc, int fr, int fq) const {
        const int row0 = u.pm * BM + wr * 64 + fr, col0 = u.pn * 128 + wc * 32 + 8 * fq;
        ssq_t rsv[2][4];
#pragma unroll
        for (int ai = 0; ai < 2; ++ai)
#pragma unroll
            for (int m = 0; m < 4; ++m) rsv[ai][m] = ssq[row0 + ai * HALF + m * 16];
#pragma unroll
        for (int ai = 0; ai < 2; ++ai)
#pragma unroll
            for (int m = 0; m < 4; ++m) { const int r = row0 + ai * HALF + m * 16; const float rs = rstd_of(rsv[ai][m], 1.0f / 2048.0f);
                f32x4 o[2];
#pragma unroll
                for (int n = 0; n < 2; ++n)
#pragma unroll
                    for (int i = 0; i < 4; ++i) { const float gt = acc[ai][0][m][n][i] * rs, up = acc[ai][1][m][n][i] * rs; o[n][i] = siluf_(gt) * up; }
                *(u32x4*)(H + (size_t)r * DFF + col0) = PACK8(o[0], o[1]); }
    }
};
struct EpiResid {
    static constexpr bool PERM = true, AFTER_DRAIN = false, F16 = false;
    float* xdst; bf16_t* xb; ssq_t* ssq_out; float alpha; int final_out;
    __device__ __forceinline__ void operator()(const Acc& acc, const Unit& u, int wr, int wc, int fr, int fq) const {
        const int row0 = u.pm * BM + wr * 64 + fr, col0 = u.pn * BM + wc * 32 + 8 * fq;
        u32x4 xv[2][2];
#define RES_LOAD(buf, g_) do { const size_t off_ = (size_t)(row0 + ((g_) >> 2) * HALF + ((g_) & 3) * 16) * DM + col0; \
        _Pragma("unroll") for (int bj = 0; bj < 2; ++bj) xv[buf][bj] = *(const u32x4*)(xb + off_ + bj * HALF); } while (0)
        RES_LOAD(0, 0);
#pragma unroll
        for (int g_ = 0; g_ < 8; ++g_) { const int ai = g_ >> 2, m = g_ & 3, r = row0 + ai * HALF + m * 16; const size_t off = (size_t)r * DM + col0; float s = 0.f;
            if (g_ + 1 < 8) RES_LOAD((g_ + 1) & 1, g_ + 1);
#pragma unroll
            for (int bj = 0; bj < 2; ++bj) { const u32x4 w = xv[g_ & 1][bj];
                const f32x4 x0 = (f32x4){h_lo(w.x), h_hi(w.x), h_lo(w.y), h_hi(w.y)}, x1 = (f32x4){h_lo(w.z), h_hi(w.z), h_lo(w.w), h_hi(w.w)};
                const f32x4 o0 = x0 + acc[ai][bj][m][0] * alpha, o1 = x1 + acc[ai][bj][m][1] * alpha;
                if (final_out) { *(f32x4*)(xdst + off + bj * HALF) = o0; *(f32x4*)(xdst + off + bj * HALF + 4) = o1; }
                else { s += (o0[0] * o0[0] + o0[1] * o0[1]) + (o0[2] * o0[2] + o0[3] * o0[3]) + (o1[0] * o1[0] + o1[1] * o1[1]) + (o1[2] * o1[2] + o1[3] * o1[3]);
                       *(u32x4*)(xb + off + bj * HALF) = (u32x4){cvt_pk_f16(o0[0], o0[1]), cvt_pk_f16(o0[2], o0[3]), cvt_pk_f16(o1[0], o1[1]), cvt_pk_f16(o1[2], o1[3])}; } }
            if (!final_out) { s += __shfl_xor(s, 16); s += __shfl_xor(s, 32); if (fq == 0) atomicAdd(ssq_out + r, ssq_fix(s)); } }
#undef RES_LOAD
    }
};
struct EpiWin {
    static constexpr bool PERM = true, AFTER_DRAIN = false, F16 = true;
    const ssq_t* ssq; bf16_t* AGLU; bf16_t* CQ; bf16_t* CKV; bf16_t* KPE; ssq_t* ssq_cq; ssq_t* ssq_ckv;
    __device__ __forceinline__ void operator()(const Acc& acc, const Unit& u, int wr, int wc, int fr, int fq) const {
        const int row0 = u.pm * BM + wr * 64 + fr, cw = wc * 32 + 8 * fq, pn = u.pn;
        ssq_t rsv[2][4];
#pragma unroll
        for (int ai = 0; ai < 2; ++ai)
#pragma unroll
            for (int m = 0; m < 4; ++m) rsv[ai][m] = ssq[row0 + ai * HALF + m * 16];
#pragma unroll
        for (int ai = 0; ai < 2; ++ai)
#pragma unroll
            for (int m = 0; m < 4; ++m) { const int r = row0 + ai * HALF + m * 16; const float rs = rstd_of(rsv[ai][m], 1.0f / 2048.0f);
                if (pn < 8) {
                    f32x4 o[2];
#pragma unroll
                    for (int n = 0; n < 2; ++n)
#pragma unroll
                        for (int i = 0; i < 4; ++i) o[n][i] = (acc[ai][0][m][n][i] * rs) * sigmoidf_(acc[ai][1][m][n][i] * rs);
                    *(u32x4*)(AGLU + (size_t)r * 1024 + pn * 128 + cw) = PACK8(o[0], o[1]);
                } else if (pn < 12) {
                    float s = 0.f;
#pragma unroll
                    for (int bj = 0; bj < 2; ++bj) { const f32x4 v0 = acc[ai][bj][m][0] * rs, v1 = acc[ai][bj][m][1] * rs;
                        s += (v0[0] * v0[0] + v0[1] * v0[1]) + (v0[2] * v0[2] + v0[3] * v0[3]) + (v1[0] * v1[0] + v1[1] * v1[1]) + (v1[2] * v1[2] + v1[3] * v1[3]);
                        if (pn < 11) *(u32x4*)(CQ + (size_t)r * 768 + (pn - 8) * 256 + bj * HALF + cw) = PACK8(v0, v1);
                        else *(u32x4*)(CKV + (size_t)r * 256 + bj * HALF + cw) = PACK8(v0, v1); }
                    s += __shfl_xor(s, 16); s += __shfl_xor(s, 32);
                    if (fq == 0) atomicAdd((pn < 11 ? ssq_cq : ssq_ckv) + r, ssq_fix(s));
                } else {
                    if (wc < 2) { const f32x4 v0 = acc[ai][0][m][0] * rs, v1 = acc[ai][0][m][1] * rs; *(u32x4*)(KPE + (size_t)r * 64 + cw) = PACK8(v0, v1); }
                } }
    }
};
struct EpiPlain {
    static constexpr bool PERM = true, AFTER_DRAIN = false, F16 = false;
    bf16_t* O; int ldc; const ssq_t* ssq; float inv_n;
    __device__ __forceinline__ void operator()(const Acc& acc, const Unit& u, int wr, int wc, int fr, int fq) const {
        const int row0 = u.pm * BM + wr * 64 + fr, col0 = u.pn * BM + wc * 32 + 8 * fq;
        ssq_t rsv[2][4];
#pragma unroll
        for (int ai = 0; ai < 2; ++ai)
#pragma unroll
            for (int m = 0; m < 4; ++m) rsv[ai][m] = ssq ? ssq[row0 + ai * HALF + m * 16] : (ssq_t)0;
#pragma unroll
        for (int ai = 0; ai < 2; ++ai)
#pragma unroll
            for (int m = 0; m < 4; ++m) { const int r = row0 + ai * HALF + m * 16; const float rs = ssq ? rstd_of(rsv[ai][m], inv_n) : 1.0f;
#pragma unroll
                for (int bj = 0; bj < 2; ++bj) { const f32x4 v0 = acc[ai][bj][m][0] * rs, v1 = acc[ai][bj][m][1] * rs; *(u32x4*)(O + (size_t)r * ldc + col0 + bj * HALF) = PACK8(v0, v1); } }
    }
};
struct EpiCq {
    static constexpr bool PERM = true, AFTER_DRAIN = false, F16 = true;
    bf16_t* QC; const ssq_t* ssq; ssq_t* ssq_qc;
    __device__ __forceinline__ void operator()(const Acc& acc, const Unit& u, int wr, int wc, int fr, int fq) const {
        const int row0 = u.pm * BM + wr * 64 + fr, col0 = u.pn * BM + wc * 32 + 8 * fq, head = u.pn >> 1;
        ssq_t rsv[2][4];
#pragma unroll
        for (int ai = 0; ai < 2; ++ai)
#pragma unroll
            for (int m = 0; m < 4; ++m) rsv[ai][m] = ssq[row0 + ai * HALF + m * 16];
#pragma unroll
        for (int ai = 0; ai < 2; ++ai)
#pragma unroll
            for (int m = 0; m < 4; ++m) { const int r = row0 + ai * HALF + m * 16; const float rs = rstd_of(rsv[ai][m], 1.0f / 2048.0f); float s = 0.f;
#pragma unroll
                for (int bj = 0; bj < 2; ++bj) { const f32x4 v0 = acc[ai][bj][m][0] * rs, v1 = acc[ai][bj][m][1] * rs;
                    s += (v0[0] * v0[0] + v0[1] * v0[1]) + (v0[2] * v0[2] + v0[3] * v0[3]) + (v1[0] * v1[0] + v1[1] * v1[1]) + (v1[2] * v1[2] + v1[3] * v1[3]);
                    *(u32x4*)(QC + (size_t)r * DM + col0 + bj * HALF) = PACK8(v0, v1); }
                s += __shfl_xor(s, 16); s += __shfl_xor(s, 32);
                if (fq == 0) atomicAdd(ssq_qc + r * 4 + head, ssq_fix(s)); }
    }
};
struct EpiMemKV {
    static constexpr bool PERM = true, AFTER_DRAIN = false, F16 = false;
    const ssq_t* ssq_mem; const float* gq; const float* gk; bf16_t* KC; bf16_t* VT; ssq_t* ssq_kc;
    __device__ __forceinline__ void operator()(const Acc& acc, const Unit& u, int wr, int wc, int fr, int fq) const {
        const int row0 = u.pm * BM + wr * 64 + fr, pn = u.pn;
#pragma unroll
        for (int ai = 0; ai < 2; ++ai)
#pragma unroll
            for (int m = 0; m < 4; ++m) { const int r = row0 + ai * HALF + m * 16; const float rs = rstd_of(ssq_mem[r], 1.0f / 2048.0f);
                if (pn < 8) { float s = 0.f;
#pragma unroll
                    for (int bj = 0; bj < 2; ++bj) { const int col = pn * BM + bj * HALF + wc * 32 + 8 * fq, d = col & 511; f32x4 v[2];
#pragma unroll
                        for (int n = 0; n < 2; ++n) { v[n] = acc[ai][bj][m][n] * rs; s += (v[n][0] * v[n][0] + v[n][1] * v[n][1]) + (v[n][2] * v[n][2] + v[n][3] * v[n][3]);
                            const f32x4 a = *(const f32x4*)(gq + d + 4 * n), b = *(const f32x4*)(gk + d + 4 * n); v[n] = v[n] * a * b; }
                        *(u32x4*)(KC + (size_t)r * DM + col) = PACK8(v[0], v[1]); }
                    s += __shfl_xor(s, 16); s += __shfl_xor(s, 32);
                    if (fq == 0) atomicAdd(ssq_kc + r * 4 + (pn >> 1), ssq_fix(s));
                } else {
                    const int b = r >> 8, mm = r & 255;
#pragma unroll
                    for (int bj = 0; bj < 2; ++bj)
#pragma unroll
                        for (int n = 0; n < 2; ++n)
#pragma unroll
                            for (int i = 0; i < 4; ++i) { const int col = (pn - 8) * BM + bj * HALF + wc * 32 + 8 * fq + 4 * n + i, h = col >> 9, d = col & 511;
                                VT[((size_t)((b * 4 + h) * 512 + d)) * 256 + mm] = (bf16_t)(cvt_pk_bf16(acc[ai][bj][m][n][i] * rs, 0.f) & 0xffffu); }
                } }
    }
};
struct EpiSoftmax {
    static constexpr bool PERM = true, AFTER_DRAIN = true, F16 = false;
    bf16_t* P; const ssq_t* ssq_qc; const ssq_t* ssq_kc;
    __device__ __forceinline__ void fused(Acc& acc, const Unit& u, int wr, int wc, int fr, int fq, LAS unsigned char* lds, int wid, int lane) const {
        LAS float* X = (LAS float*)lds; LAS float* Y = X + 1024;
        const int h = u.pn, b = u.pm >> 5;
        f32x4 rk[2][2];
#pragma unroll
        for (int bj = 0; bj < 2; ++bj)
#pragma unroll
            for (int n = 0; n < 2; ++n)
#pragma unroll
                for (int i = 0; i < 4; ++i) { const int mm = bj * HALF + wc * 32 + 8 * fq + 4 * n + i; rk[bj][n][i] = rstd_of(ssq_kc[(b * 256 + mm) * 4 + h], 1.0f / 512.0f) * XSCALE; }
#pragma unroll
        for (int ai = 0; ai < 2; ++ai)
#pragma unroll
            for (int m = 0; m < 4; ++m) { const int rl = ai * HALF + wr * 64 + m * 16 + fr, r = u.pm * BM + rl; const float rq = rstd_of(ssq_qc[r * 4 + h], 1.0f / 512.0f); float mx = -3.0e38f;
#pragma unroll
                for (int bj = 0; bj < 2; ++bj)
#pragma unroll
                    for (int n = 0; n < 2; ++n) { const f32x4 v = acc[ai][bj][m][n] * rk[bj][n] * rq; acc[ai][bj][m][n] = v; mx = fmaxf(fmaxf(mx, fmaxf(v[0], v[1])), fmaxf(v[2], v[3])); }
                mx = fmaxf(mx, __shfl_xor(mx, 16)); mx = fmaxf(mx, __shfl_xor(mx, 32));
                if (fq == 0) X[rl * 4 + wc] = mx; }
        LDS_WAIT(); __builtin_amdgcn_s_barrier(); asm volatile("" ::: "memory");
#pragma unroll
        for (int ai = 0; ai < 2; ++ai)
#pragma unroll
            for (int m = 0; m < 4; ++m) { const int rl = ai * HALF + wr * 64 + m * 16 + fr; const float mx = fmaxf(fmaxf(X[rl * 4 + 0], X[rl * 4 + 1]), fmaxf(X[rl * 4 + 2], X[rl * 4 + 3])); float s = 0.f;
#pragma unroll
                for (int bj = 0; bj < 2; ++bj)
#pragma unroll
                    for (int n = 0; n < 2; ++n) { f32x4 v = acc[ai][bj][m][n];
#pragma unroll
                        for (int i = 0; i < 4; ++i) { v[i] = __builtin_amdgcn_exp2f(v[i] - mx); s += v[i]; }
                        acc[ai][bj][m][n] = v; }
                s += __shfl_xor(s, 16); s += __shfl_xor(s, 32);
                if (fq == 0) Y[rl * 4 + wc] = s; }
        LDS_WAIT(); __builtin_amdgcn_s_barrier(); asm volatile("" ::: "memory");
#pragma unroll
        for (int ai = 0; ai < 2; ++ai)
#pragma unroll
            for (int m = 0; m < 4; ++m) { const int rl = ai * HALF + wr * 64 + m * 16 + fr, r = u.pm * BM + rl; const float inv = 1.0f / ((Y[rl * 4 + 0] + Y[rl * 4 + 1]) + (Y[rl * 4 + 2] + Y[rl * 4 + 3]));
#pragma unroll
                for (int bj = 0; bj < 2; ++bj) { const f32x4 v0 = acc[ai][bj][m][0] * inv, v1 = acc[ai][bj][m][1] * inv;
                    *(u32x4*)(P + (size_t)r * 1024 + h * 256 + bj * HALF + wc * 32 + 8 * fq) = PACK8(v0, v1); } }
        LDS_WAIT(); __builtin_amdgcn_s_barrier(); asm volatile("" ::: "memory");
    }
};
}

namespace mla {
constexpr int NW = 8, QBLK = 32, KVBLK = 64, LDQ = 1536, LDK = 1536, LDV = 2048, LDO = 2048;
constexpr int SHM_V = 64 * 128 * 2, SHM_K = 64 * 192 * 2, SHM_ATTN = 4 * SHM_V + 3 * SHM_K + NW * 64 * 4;
constexpr float THRL = 8.0f;
#define KSWZ(row, colB) ((row) * 384 + ((colB) ^ ((((row) >> 1) & 7) << 4)))
#define SBAR() __builtin_amdgcn_sched_barrier(0)
__device__ __forceinline__ int crow(int r, int hi) { return (r & 3) + 8 * (r >> 2) + 4 * hi; }
__device__ __forceinline__ int v_st(int k, int c) { const int kk = (k & ~0xC) | ((k & 4) << 1) | ((k & 8) >> 1); return ((kk >> 3) * 4 + (c >> 5)) * 512 + ((kk & 7) * 32 + (c & 31)) * 2; }
__device__ __forceinline__ int v_rd_base(int lane) { return ((lane & 3) << 3) | (((lane >> 2) & 3) << 6) | (((lane >> 4) & 1) << 5) | (((lane >> 5) & 1) << 8); }
constexpr int v_rd_off(int d0, int ks, int half) { return d0 * 512 + ks * 4096 + half * 2048; }
template <int OFF> __device__ __forceinline__ s16x4 tr_read(int vb) {
    s16x4 r; asm volatile("ds_read_b64_tr_b16 %0, %1 offset:%2" : "=&v"(r) : "v"(vb), "i"(OFF) : "memory"); return r;
}
template <int D0> __device__ __forceinline__ void pv_one(f32x16& od, int vb, bf16x8 pa0, bf16x8 pa1, bf16x8 pa2, bf16x8 pa3) {
    const s16x4 l0 = tr_read<v_rd_off(D0, 0, 0)>(vb), h0 = tr_read<v_rd_off(D0, 0, 1)>(vb), l1 = tr_read<v_rd_off(D0, 1, 0)>(vb), h1 = tr_read<v_rd_off(D0, 1, 1)>(vb);
    const s16x4 l2 = tr_read<v_rd_off(D0, 2, 0)>(vb), h2 = tr_read<v_rd_off(D0, 2, 1)>(vb), l3 = tr_read<v_rd_off(D0, 3, 0)>(vb), h3 = tr_read<v_rd_off(D0, 3, 1)>(vb);
    asm volatile("s_waitcnt lgkmcnt(0)" ::: "memory"); SBAR();
#define PK(L, H) (bf16x8){L[0], L[1], L[2], L[3], H[0], H[1], H[2], H[3]}
    od = __builtin_amdgcn_mfma_f32_32x32x16_bf16(pa0, PK(l0, h0), od, 0, 0, 0);
    od = __builtin_amdgcn_mfma_f32_32x32x16_bf16(pa1, PK(l1, h1), od, 0, 0, 0);
    od = __builtin_amdgcn_mfma_f32_32x32x16_bf16(pa2, PK(l2, h2), od, 0, 0, 0);
    od = __builtin_amdgcn_mfma_f32_32x32x16_bf16(pa3, PK(l3, h3), od, 0, 0, 0);
#undef PK
}
__device__ __forceinline__ void sm_pv(f32x16& p0, f32x16& p1, float& m_reg, float& l_reg, f32x16 (&o)[4], float* al_l, int vb, int r32, int hi, bool first) {
    float pmax = p0[0];
#pragma unroll
    for (int r = 1; r < 16; ++r) pmax = fmaxf(pmax, p0[r]);
#pragma unroll
    for (int r = 0; r < 16; ++r) pmax = fmaxf(pmax, p1[r]);
    { auto rr = __builtin_amdgcn_permlane32_swap(__float_as_uint(pmax), __float_as_uint(pmax), false, false);
      pmax = fmaxf(__uint_as_float(rr[0]), __uint_as_float(rr[1])); }
    if (first) {
        m_reg += pmax;
#pragma unroll
        for (int r = 0; r < 16; ++r) { p0[r] -= pmax; p1[r] -= pmax; }
    } else if (!__all(pmax <= THRL)) {
        const float dl = fmaxf(pmax, 0.f); const float alpha = __builtin_amdgcn_exp2f(-dl); m_reg += dl; l_reg *= alpha;
#pragma unroll
        for (int r = 0; r < 16; ++r) { p0[r] -= dl; p1[r] -= dl; }
        if (hi == 0) al_l[r32] = alpha;
        LDS_WAIT();
#pragma unroll
        for (int d = 0; d < 4; ++d)
#pragma unroll
            for (int r = 0; r < 16; ++r) o[d][r] *= al_l[crow(r, hi)];
    }
#pragma unroll
    for (int r = 0; r < 16; ++r) { p0[r] = __builtin_amdgcn_exp2f(p0[r]); p1[r] = __builtin_amdgcn_exp2f(p1[r]); }
    typedef float f32x2v __attribute__((ext_vector_type(2)));
    f32x2v ps2 = (f32x2v){0.f, 0.f};
#pragma unroll
    for (int r = 0; r < 16; r += 2) { ps2 += (f32x2v){p0[r], p0[r + 1]}; ps2 += (f32x2v){p1[r], p1[r + 1]}; }
    float ps = ps2.x + ps2.y;
    { auto rr = __builtin_amdgcn_permlane32_swap(__float_as_uint(ps), __float_as_uint(ps), false, false);
      ps = __uint_as_float(rr[0]) + __uint_as_float(rr[1]); }
    l_reg += ps;
    bf16x8 pa0, pa1, pa2, pa3;
#define PK4(P, BASE, OUT) do { unsigned a0 = cvt_pk_bf16(P[BASE + 0], P[BASE + 1]), a1 = cvt_pk_bf16(P[BASE + 2], P[BASE + 3]);   \
    unsigned b0 = cvt_pk_bf16(P[BASE + 4], P[BASE + 5]), b1 = cvt_pk_bf16(P[BASE + 6], P[BASE + 7]);                              \
    auto r0 = __builtin_amdgcn_permlane32_swap(a0, b0, false, false); auto r1 = __builtin_amdgcn_permlane32_swap(a1, b1, false, false); \
    u32x4 w = {r0[0], r1[0], r0[1], r1[1]}; OUT = *reinterpret_cast<bf16x8*>(&w); } while (0)
    PK4(p0, 0, pa0); PK4(p0, 8, pa1); PK4(p1, 0, pa2); PK4(p1, 8, pa3);
#undef PK4
    typedef short v4i16_t __attribute__((ext_vector_type(4)));
    const LAS char* vp = (const LAS char*)(__UINTPTR_TYPE__)(unsigned)vb;
    const bf16x8 pa[4] = {pa0, pa1, pa2, pa3};
#pragma unroll
    for (int ks = 0; ks < 4; ++ks)
#pragma unroll
        for (int d0 = 0; d0 < 4; ++d0) {
            const s16x4 lo = __builtin_bit_cast(s16x4, __builtin_amdgcn_ds_read_tr16_b64_v4i16((LAS v4i16_t*)(vp + v_rd_off(d0, ks, 0))));
            const s16x4 hh = __builtin_bit_cast(s16x4, __builtin_amdgcn_ds_read_tr16_b64_v4i16((LAS v4i16_t*)(vp + v_rd_off(d0, ks, 1))));
            o[d0] = __builtin_amdgcn_mfma_f32_32x32x16_bf16(pa[ks], (bf16x8){lo[0], lo[1], lo[2], lo[3], hh[0], hh[1], hh[2], hh[3]}, o[d0], 0, 0, 0);
        }
}
__device__ __forceinline__ void attn_unit(int b, int h, int qb, const bf16_t* __restrict__ QF, const bf16_t* __restrict__ KF, const bf16_t* __restrict__ KVR, bf16_t* __restrict__ MIX, char* lds) {
    int tid_ = threadIdx.x; asm volatile("" : "+v"(tid_));
    const int tid = tid_, wid = __builtin_amdgcn_readfirstlane(tid >> 6), lane = tid & 63, r32 = lane & 31, hi = lane >> 5;
    char* V_lds = lds; char* K_lds = lds + 4 * SHM_V;
    float* ws = (float*)(lds + 4 * SHM_V + 3 * SHM_K) + wid * 64; float* li_l = ws; float* al_l = ws + 32;
    const long rowbase = (long)b * SEQ; const int q0 = qb * 256;
    float m_reg = 0.f, l_reg = 0.f; f32x16 o[4] = {}; bf16x8 qr[12];
    const bf16_t* Qw = QF + (rowbase + q0 + wid * QBLK + r32) * LDQ + h * 192 + hi * 8;
#pragma unroll
    for (int d0 = 0; d0 < 12; ++d0) qr[d0] = *reinterpret_cast<const bf16x8*>(Qw + d0 * 16);
    VM_WAIT();
#pragma unroll
    for (int d0 = 0; d0 < 12; ++d0) asm volatile("" : "+v"(qr[d0]));
    const bf16_t* Kh = KF + rowbase * LDK + h * 192; const bf16_t* Vh = KVR + rowbase * LDV + h * 256 + 128;
    int koff[3], voff[2];
#pragma unroll
    for (int i = 0; i < 3; ++i) { const int S = (wid * 3 + i) * 64 + lane, row = S / 24, ch = (S % 24) ^ ((row >> 1) & 7); koff[i] = row * LDK + ch * 8; }
#pragma unroll
    for (int i = 0; i < 2; ++i) { const int S = (wid * 2 + i) * 64 + lane, sub = S >> 5, within = S & 31, kk = ((sub >> 2) << 3) | (within >> 2), c = ((sub & 3) << 5) | ((within & 3) << 3);
        const int k = (kk & ~0xC) | ((kk & 4) << 1) | ((kk & 8) >> 1); voff[i] = k * LDV + c; }
    const int vb0 = (int)(uintptr_t)V_lds + v_rd_base(lane);
    LAS unsigned char* Kl = (LAS unsigned char*)(unsigned)(uintptr_t)K_lds; LAS unsigned char* Vl = (LAS unsigned char*)(unsigned)(uintptr_t)V_lds;
#define DMA_TILE(t_, kbuf_, vbo_) do { const bf16_t* kg_ = Kh + (long)(t_) * KVBLK * LDK; const bf16_t* vg_ = Vh + (long)(t_) * KVBLK * LDV; \
    _Pragma("unroll") for (int i = 0; i < 3; ++i) __builtin_amdgcn_global_load_lds((const unsigned*)(kg_ + koff[i]), (LAS unsigned*)(Kl + (kbuf_) * SHM_K + (wid * 3 + i) * 1024), 16, 0, 0); \
    _Pragma("unroll") for (int i = 0; i < 2; ++i) __builtin_amdgcn_global_load_lds((const unsigned*)(vg_ + voff[i]), (LAS unsigned*)(Vl + (vbo_) + (wid * 2 + i) * 1024), 16, 0, 0); } while (0)
#define WAIT_BAR(N) do { asm volatile("s_waitcnt vmcnt(" #N ") lgkmcnt(0)" ::: "memory"); __builtin_amdgcn_s_barrier(); asm volatile("" ::: "memory"); } while (0)
    const int NT = 4 * qb + 4, tmax = 4 * qb + (wid >> 1);
    const bool late = wid >= 4;
    f32x16 p0 = {}, p1 = {};
    int vprev = 3 * SHM_V, vcur = 0, vnext = SHM_V, vnn = 2 * SHM_V;
    int kcur = 0, knext = 1, knn = 2;
    DMA_TILE(0, 0, 0); DMA_TILE(1, 1, SHM_V);
    WAIT_BAR(5);
    for (int j = 0; j < NT; ++j) {
        if (j + 2 < NT) DMA_TILE(j + 2, knn, vnn);
        if (late && j >= 1 && j - 1 <= tmax) sm_pv(p0, p1, m_reg, l_reg, o, al_l, vb0 + vprev, r32, hi, j == 1);
        if (j <= tmax) {
#pragma unroll
            for (int r = 0; r < 16; ++r) { p0[r] = -m_reg; p1[r] = -m_reg; }
            const char* Ks = K_lds + kcur * SHM_K;
            bf16x8 ka[4], kb[4];
#define KRD(dst, D0B) do { _Pragma("unroll") for (int i = 0; i < 2; ++i) { const int cb = (((D0B) + i) * 16 + hi * 8) * 2; \
    dst[2 * i] = *reinterpret_cast<const bf16x8*>(Ks + KSWZ(r32, cb)); dst[2 * i + 1] = *reinterpret_cast<const bf16x8*>(Ks + KSWZ(32 + r32, cb)); } } while (0)
#define KMM(src, D0B) do { _Pragma("unroll") for (int i = 0; i < 2; ++i) { p0 = __builtin_amdgcn_mfma_f32_32x32x16_bf16(src[2 * i], qr[(D0B) + i], p0, 0, 0, 0); \
    p1 = __builtin_amdgcn_mfma_f32_32x32x16_bf16(src[2 * i + 1], qr[(D0B) + i], p1, 0, 0, 0); } } while (0)
            KRD(ka, 0); KRD(kb, 2); SBAR();
            KMM(ka, 0); SBAR(); KRD(ka, 4); SBAR(); KMM(kb, 2); SBAR(); KRD(kb, 6); SBAR();
            KMM(ka, 4); SBAR(); KRD(ka, 8); SBAR(); KMM(kb, 6); SBAR(); KRD(kb, 10); SBAR();
            KMM(ka, 8); SBAR(); KMM(kb, 10);
#undef KRD
#undef KMM
        }
        if (!late && j <= tmax) sm_pv(p0, p1, m_reg, l_reg, o, al_l, vb0 + vcur, r32, hi, j == 0);
        if (j + 2 < NT) WAIT_BAR(5); else WAIT_BAR(0);
        { const int t = vprev; vprev = vcur; vcur = vnext; vnext = vnn; vnn = t; }
        { const int t = kcur; kcur = knext; knext = knn; knn = t; }
    }
    if (late && NT - 1 <= tmax) sm_pv(p0, p1, m_reg, l_reg, o, al_l, vb0 + vprev, r32, hi, false);
    if (hi == 0) li_l[r32] = l_reg;
    LDS_WAIT();
    float rli[16];
#pragma unroll
    for (int r = 0; r < 16; ++r) rli[r] = __builtin_amdgcn_rcpf(li_l[crow(r, hi)]);
    bf16_t* Ow = MIX + (rowbase + q0 + wid * QBLK) * LDO + 1024 + h * 128;
#pragma unroll
    for (int r = 0; r < 16; ++r) { const int orow = crow(r, hi);
#pragma unroll
        for (int d0 = 0; d0 < 4; ++d0) Ow[(long)orow * LDO + d0 * 32 + r32] = (bf16_t)(cvt_pk_bf16(o[d0][r] * rli[r], 0.f) & 0xffffu); }
    WAIT_BAR(0);
#undef DMA_TILE
#undef WAIT_BAR
}
#undef SBAR
}

struct Args { const void* in[32]; float* out; unsigned char* ws; };

__device__ const float INV_FREQ[32] = {
    1.000000000e+00f, 7.498942018e-01f, 5.623413324e-01f, 4.216965139e-01f, 3.162277639e-01f, 2.371373922e-01f, 1.778279394e-01f, 1.333521456e-01f,
    1.000000015e-01f, 7.498941571e-02f, 5.623412877e-02f, 4.216964915e-02f, 3.162277862e-02f, 2.371373586e-02f, 1.778279431e-02f, 1.333521493e-02f,
    9.999999776e-03f, 7.498942316e-03f, 5.623413250e-03f, 4.216964822e-03f, 3.162277862e-03f, 2.371373819e-03f, 1.778279431e-03f, 1.333521446e-03f,
    1.000000047e-03f, 7.498941850e-04f, 5.623413017e-04f, 4.216965463e-04f, 3.162277862e-04f, 2.371373848e-04f, 1.778279402e-04f, 1.333521504e-04f};

__device__ __forceinline__ void transpose_job(const float* W, int ldw, int K, int ncols, const float* gain, bf16_t* WT, int mode, int off, int f16,
                                              LAS float* T, int& base, int bx, int G, int tid) {
    const int nblk = (ncols + 127) >> 7, nitems = (K >> 7) * nblk;
    const int first = (bx + G - (base % G)) % G;
    f32x4 R[8];
#define TJ_LOAD(it_) do { const int kb_ = (it_) / nblk, nb_ = (it_) % nblk; \
    _Pragma("unroll") for (int i = 0; i < 8; ++i) { const int idx = tid + 512 * i, row = idx >> 5, n = nb_ * 128 + (idx & 31) * 4; \
        R[i] = (n < ncols) ? *(const f32x4*)(W + (size_t)(kb_ * 128 + row) * ldw + n) : (f32x4){0.f, 0.f, 0.f, 0.f}; } } while (0)
    if (first < nitems) TJ_LOAD(first);
    for (int it = first; it < nitems; it += G) {
        const int kb = it / nblk, nb = it % nblk;
        __syncthreads();
#pragma unroll
        for (int i = 0; i < 8; ++i) { const int idx = tid + 512 * i, row = idx >> 5, c4 = (idx & 31) * 4; const float gsc = gain ? gain[kb * 128 + row] : 1.0f;
            *(LAS f32x4*)(T + row * 128 + (c4 ^ (((row >> 3) & 7) << 2))) = R[i] * gsc; }
        if (it + G < nitems) TJ_LOAD(it + G);
        __syncthreads();
        const int c = tid & 15;
#pragma unroll
        for (int i = 0; i < 4; ++i) { const int nl = 4 * ((tid >> 6) + 8 * i) + ((tid >> 4) & 3), n = nb * 128 + nl; const LAS float* sp = T + (8 * c) * 128 + (nl ^ ((c & 7) << 2));
            u32x4 o; if (f16) { o.x = cvt_pk_f16(sp[0 * 128], sp[1 * 128]); o.y = cvt_pk_f16(sp[2 * 128], sp[3 * 128]); o.z = cvt_pk_f16(sp[4 * 128], sp[5 * 128]); o.w = cvt_pk_f16(sp[6 * 128], sp[7 * 128]); }
            else { o.x = cvt_pk_bf16(sp[0 * 128], sp[1 * 128]); o.y = cvt_pk_bf16(sp[2 * 128], sp[3 * 128]); o.z = cvt_pk_bf16(sp[4 * 128], sp[5 * 128]); o.w = cvt_pk_bf16(sp[6 * 128], sp[7 * 128]); }
            const int drow = (mode == 0) ? (n + off) : (((n >> 7) << 8) + (n & 127) + off);
            if (n < ncols) *(u32x4*)(WT + (size_t)drow * K + kb * 128 + 8 * c) = o; }
    }
#undef TJ_LOAD
    base += nitems;
}


#define XB_TMO      128
#define XB_XCNT(j)  (256  + 64 * (j))
#define XB_XSUB(j)  (1280 + 64 * (j))
#define XB_XGEN(j)  (2304 + 64 * (j))
#define XB_TOP      3328
#define XB_TOPGEN   3392
#define XCD_BAR_WORDS 3456
#define XB_SPIN_CAP (1u << 18)
__device__ __forceinline__ unsigned xb_ld(unsigned* p)              { return __hip_atomic_load(p, __ATOMIC_RELAXED, __HIP_MEMORY_SCOPE_AGENT); }
__device__ __forceinline__ unsigned xb_add(unsigned* p, unsigned v) { return __hip_atomic_fetch_add(p, v, __ATOMIC_RELAXED, __HIP_MEMORY_SCOPE_AGENT); }
__device__ __forceinline__ unsigned xb_xcc_id() { return (unsigned)__builtin_amdgcn_s_getreg((3 << 11) | 20) & 0xFu; }
#define XB_SPIN(cond, bar) do { unsigned _sp = 0; while (cond) { __builtin_amdgcn_s_sleep(1); \
    if ((++_sp & 255u) == 0u) { if (xb_ld(&(bar)[XB_TMO])) break; if (_sp > XB_SPIN_CAP) { atomicAdd(&(bar)[XB_TMO], 1u); break; } } } } while (0)
__device__ __forceinline__ void xcd_barrier_complete(unsigned* bar, unsigned x, unsigned& nloc, unsigned& nx) {
    const unsigned G = gridDim.x * gridDim.y * gridDim.z;
    unsigned sum, cnt, mine, sp = 0u;
    for (;;) {
        sum = 0u; cnt = 0u; mine = 0u;
#pragma unroll
        for (unsigned j = 0; j < 16; ++j) { const unsigned c = xb_ld(&bar[XB_XCNT(j)]); sum += c; cnt += (c > 0u) ? 1u : 0u; mine = (j == x) ? c : mine; }
        if (sum == G) break;
        __builtin_amdgcn_s_sleep(1);
        if ((++sp & 255u) == 0u) { if (xb_ld(&bar[XB_TMO])) break; if (sp > XB_SPIN_CAP) { atomicAdd(&bar[XB_TMO], 1u); break; } }
    }
    nloc = mine > 0u ? mine : 1u; nx = cnt > 0u ? cnt : 1u;
}
__device__ __forceinline__ void xcd_barrier(unsigned* bar, volatile LAS unsigned* st) {
    asm volatile("s_waitcnt vmcnt(0)" ::: "memory");
    __syncthreads();
    if (threadIdx.x == 0) {
        const unsigned x = xb_xcc_id();
        __builtin_amdgcn_s_waitcnt(0);
        unsigned nloc = st[0], nx = st[1];
        if (nloc == 0u) { xcd_barrier_complete(bar, x, nloc, nx); st[0] = nloc; st[1] = nx; }
        const unsigned old = xb_add(&bar[XB_XSUB(x)], 1u);
        const unsigned gen = old / nloc;
        if (old + 1u == (gen + 1u) * nloc) {
            __builtin_amdgcn_fence(__ATOMIC_RELEASE, "agent");
            asm volatile("s_waitcnt vmcnt(0)" ::: "memory");
            const unsigned og = xb_add(&bar[XB_TOP], 1u);
            const unsigned tg = og / nx;
            if (og + 1u == (tg + 1u) * nx) xb_add(&bar[XB_TOPGEN], 1u);
            else XB_SPIN(xb_ld(&bar[XB_TOPGEN]) == tg, bar);
            __builtin_amdgcn_fence(__ATOMIC_ACQUIRE, "agent");
            xb_add(&bar[XB_XGEN(x)], 1u);
            asm volatile("s_waitcnt vmcnt(0)" ::: "memory");
        } else {
            XB_SPIN(xb_ld(&bar[XB_XGEN(x)]) == gen, bar);
            __builtin_amdgcn_fence(__ATOMIC_ACQUIRE, "agent");
            asm volatile("s_waitcnt vmcnt(0)" ::: "memory");
        }
    }
    __syncthreads();
}

__global__ void __launch_bounds__(512, 2) fwd_megakernel(Args a) {
    extern __shared__ __attribute__((aligned(16))) unsigned char lds_raw[];
    cg::grid_group grid = cg::this_grid();
    LAS unsigned char* lds = (LAS unsigned char*)lds_raw;
    int tid = threadIdx.x;
#define lane (tid & 63)
#define wave (__builtin_amdgcn_readfirstlane(tid >> 6))
    int G = gridDim.x, bx = blockIdx.x;
#define vcu ((G % 8 == 0) ? (bx % 8) * (G / 8) + bx / 8 : bx)
#define NGW (G * 8)
#define gw (vcu * 8 + wave)
    unsigned char* ws = a.ws;
    const float* x_in = (const float*)a.in[0];
    float* out = a.out;
#define PHASE_FENCE() do { asm volatile("" : "+s"(ws)); asm volatile("" : "+s"(out)); asm volatile("" : "+v"(tid)); asm volatile("" : "+s"(G)); asm volatile("" : "+s"(bx)); } while (0)
#define GAS __attribute__((address_space(1)))
#define WSG ((GAS unsigned char*)ws)
#define ssq ((ssq_t*)(WSG + WS_SSQ))
#define PAR ((const float*)(WSG + WS_PAR))
#define XB ((bf16_t*)(WSG + WS_XB))
#define HB ((bf16_t*)(WSG + WS_H))
#define KVR ((bf16_t*)(WSG + WS_KVR))
#define MIX ((bf16_t*)(WSG + WS_MIX))
#define MEMB ((bf16_t*)(WSG + WS_MEMB))
#define AGLU ((bf16_t*)(WSG + WS_H + H_AGLU))
#define CQ ((bf16_t*)(WSG + WS_H + H_CQ))
#define CKV ((bf16_t*)(WSG + WS_H + H_CKV))
#define KPE ((bf16_t*)(WSG + WS_H + H_KPE))
#define QF ((bf16_t*)(WSG + WS_H + H_QF))
#define KF ((bf16_t*)(WSG + WS_H + H_KF))
#define QC ((bf16_t*)(WSG + WS_H + H_QC))
#define PC ((bf16_t*)(WSG + WS_H + H_PC))
#define OC ((bf16_t*)(WSG + WS_H + H_OC))
#define WPTR(l, o) ((bf16_t*)(WSG + WS_W + (size_t)(l) * LW + (o)))
#define PARL(l, o) (PAR + PAR_L0 + (l) * PAR_LS + (o))

#define GRID_BAR() xcd_barrier((unsigned*)(GAS unsigned*)(WSG + WS_CTL), (volatile LAS unsigned*)(lds + 139 * 1024))
    if (tid == 0) { ((volatile LAS unsigned*)(lds + 139 * 1024))[0] = 0u; ((volatile LAS unsigned*)(lds + 139 * 1024))[1] = 0u;
                    (void)xb_add((unsigned*)(GAS unsigned*)(WSG + WS_CTL) + XB_XCNT(xb_xcc_id()), 1u); }
    __syncthreads();
#ifdef TPROBE
#define STAMP(k) do { if (tid == 0) ((LAS unsigned long long*)(lds + 140 * 1024))[k] = __builtin_amdgcn_s_memrealtime(); } while (0)
#else
#define STAMP(k) do {} while (0)
#endif
    STAMP(0);
    {
        for (int i = bx * 512 + tid; i < ZERO_COUNT; i += G * 512) ssq[i] = (ssq_t)0;
        { float* par = (float*)(WSG + WS_PAR); const int gt = bx * 512 + tid, GT = G * 512;
          for (int i = gt; i < M; i += GT) ((int*)par)[PAR_POS + i] = ((const int*)a.in[2])[i];
          for (int i = gt; i < 2 * 31744; i += GT) { const int l = i / 31744, j = i % 31744; par[PAR_L0 + l * PAR_LS + PAR_CONVW + j] = ((const float*)a.in[9])[i]; }
          for (int i = gt; i < 2 * 1024; i += GT) { const int l = i >> 10, j = i & 1023; float* pl = par + PAR_L0 + l * PAR_LS;
              pl[PAR_CONVB + j] = ((const float*)a.in[10])[i]; pl[PAR_LNG + j] = ((const float*)a.in[11])[i]; pl[PAR_LNB + j] = ((const float*)a.in[12])[i];
              if (j < 512) { pl[PAR_CQN + j] = ((const float*)a.in[25])[l * 512 + j]; pl[PAR_CKN + j] = ((const float*)a.in[26])[l * 512 + j]; }
              if (j < 192) { pl[PAR_QN + j] = ((const float*)a.in[17])[l * 192 + j]; pl[PAR_KN + j] = ((const float*)a.in[18])[l * 192 + j]; } } }
        for (int l = 0; l < 2; ++l) { u32x4* p = (u32x4*)(WPTR(l, W_IN) + (size_t)NIN * DM); const int n16 = (NINP - NIN) * DM / 8;
            for (int i = bx * 512 + tid; i < n16; i += G * 512) p[i] = (u32x4){0u, 0u, 0u, 0u}; }
        for (int row = gw; row < M + MMEM; row += NGW) {
            const bool is_x = row < M; const int rr = is_x ? row : row - M;
            const float* src = (is_x ? x_in : (const float*)a.in[1]) + (size_t)rr * DM; bf16_t* dst = (is_x ? XB : MEMB) + (size_t)rr * DM;
            float s = 0.f;
#pragma unroll
            for (int j = 0; j < 8; ++j) { const f32x4 v = *(const f32x4*)(src + 256 * j + 4 * lane); s += (v[0] * v[0] + v[1] * v[1]) + (v[2] * v[2] + v[3] * v[3]);
                *(u32x2*)(dst + 256 * j + 4 * lane) = is_x ? (u32x2){cvt_pk_f16(v[0], v[1]), cvt_pk_f16(v[2], v[3])} : (u32x2){cvt_pk_bf16(v[0], v[1]), cvt_pk_bf16(v[2], v[3])}; }
            s = wave_sum(s);
            if (lane == 0) ssq[(is_x ? NZ_X0 : NZ_MEM) + rr] = ssq_fix(s);
        }
        LAS float* scr = (LAS float*)lds;
        int base = 0;
#pragma unroll 1
        for (int jb = 0; jb < 32; ++jb) {
            const int l = jb >> 4, j = jb & 15;
            const float* Wb = nullptr; const float* gb = nullptr; int ldw = DM, Kk = DM, nc = DM, mode = 0, off = 0, c0 = 0; size_t wo = 0, lstride = (size_t)DM * DM;
            switch (j) {
                case 0:  Wb = (const float*)a.in[4];  gb = (const float*)a.in[3];  ldw = DFF; Kk = DM;  nc = DFF;  mode = 1; off = 0;    wo = W_GU1; lstride = (size_t)DM * DFF; break;
                case 1:  Wb = (const float*)a.in[5];  gb = (const float*)a.in[3];  ldw = DFF; Kk = DM;  nc = DFF;  mode = 1; off = 128;  wo = W_GU1; lstride = (size_t)DM * DFF; break;
                case 2:  Wb = (const float*)a.in[6];  gb = nullptr; ldw = DM;  Kk = DFF; nc = DM;   mode = 0; off = 0;    wo = W_D1;  lstride = (size_t)DM * DFF; break;
                case 3:  Wb = (const float*)a.in[8];  gb = (const float*)a.in[7];  ldw = NIN; Kk = DM;  nc = 1024; mode = 1; off = 0;    wo = W_IN;  lstride = (size_t)DM * NIN; c0 = 0; break;
                case 4:  Wb = (const float*)a.in[8];  gb = (const float*)a.in[7];  ldw = NIN; Kk = DM;  nc = 1024; mode = 1; off = 128;  wo = W_IN;  lstride = (size_t)DM * NIN; c0 = 1024; break;
                case 5:  Wb = (const float*)a.in[8];  gb = (const float*)a.in[7];  ldw = NIN; Kk = DM;  nc = NIN - 2048; mode = 0; off = 2048; wo = W_IN; lstride = (size_t)DM * NIN; c0 = 2048; break;
                case 6:  Wb = (const float*)a.in[14]; gb = (const float*)a.in[13]; ldw = 1536; Kk = 768; nc = 1536; mode = 0; off = 0;   wo = W_QB;  lstride = (size_t)768 * 1536; break;
                case 7:  Wb = (const float*)a.in[16]; gb = (const float*)a.in[15]; ldw = 2048; Kk = 256; nc = 2048; mode = 0; off = 0;   wo = W_KVB; lstride = (size_t)256 * 2048; break;
                case 8:  Wb = (const float*)a.in[19]; gb = nullptr; wo = W_OUT; break;
                case 9:  Wb = (const float*)a.in[22]; gb = (const float*)a.in[20]; wo = W_CQ; break;
                case 10: Wb = (const float*)a.in[23]; gb = (const float*)a.in[21]; wo = W_CKV; break;
                case 11: Wb = (const float*)a.in[24]; gb = (const float*)a.in[21]; wo = W_CKV; off = 2048; break;
                case 12: Wb = (const float*)a.in[27]; gb = nullptr; wo = W_CO; break;
                case 13: Wb = (const float*)a.in[29]; gb = (const float*)a.in[28]; ldw = DFF; Kk = DM;  nc = DFF;  mode = 1; off = 0;    wo = W_GU2; lstride = (size_t)DM * DFF; break;
                case 14: Wb = (const float*)a.in[30]; gb = (const float*)a.in[28]; ldw = DFF; Kk = DM;  nc = DFF;  mode = 1; off = 128;  wo = W_GU2; lstride = (size_t)DM * DFF; break;
                default: Wb = (const float*)a.in[31]; gb = nullptr; ldw = DM;  Kk = DFF; nc = DM;   mode = 0; off = 0;    wo = W_D2;  lstride = (size_t)DM * DFF; break;
            }
            const float* Wp = Wb + (size_t)l * lstride + c0;
            const float* gp = gb ? gb + (size_t)l * Kk : nullptr;
            const int f16w = (j <= 1 || (j >= 3 && j <= 5) || j == 9 || j == 13 || j == 14) ? 1 : 0;
            transpose_job(Wp, ldw, Kk, nc, gp, WPTR(l, wo), mode, off, f16w, scr, base, bx, G, tid);
        }
    }
    grid.sync(); PHASE_FENCE(); STAMP(1);

    STAMP(2);
#pragma unroll 1
    for (int l = 0; l < 2; ++l) {
        {
            pg8::Gemm g{XB, WPTR(l, W_GU1), DM, DM, DM, 0}; pg8::Order S; S.init(M / 256, 2 * DFF / 256, G, bx);
            pg8::EpiGateUp E{HB, ssq + ssqx(4 * l + 0)};
            pg8::gemm_phase<pg8::EpiGateUp, pg8::Order, true, true>(lds, g, S, E);
        }
        GRID_BAR(); PHASE_FENCE(); STAMP(3 + 13 * l);
        {
            pg8::Gemm g{HB, WPTR(l, W_D1), DFF, DFF, DFF, 0}; pg8::Order S; S.init(M / 256, DM / 256, G, bx);
            pg8::EpiResid E{(float*)(GAS float*)out, XB, ssq + ssqx(4 * l + 1), 0.5f, 0};
            pg8::gemm_phase<pg8::EpiResid, pg8::Order, true, true>(lds, g, S, E);
        }
        GRID_BAR(); PHASE_FENCE(); STAMP(4 + 13 * l);
        {
            pg8::Gemm g{XB, WPTR(l, W_IN), DM, DM, DM, 0}; pg8::Order S; S.init(M / 256, NINP / 256, G, bx);
            pg8::EpiWin E{ssq + ssqx(4 * l + 1), AGLU, CQ, CKV, KPE, ssq + Z_CQ + l * M, ssq + Z_CKV + l * M};
            pg8::gemm_phase<pg8::EpiWin, pg8::Order, true, true>(lds, g, S, E);
        }
        {
            pg8::Gemm g{MEMB, WPTR(l, W_CKV), DM, DM, DM, 0}; pg8::Order S; S.init(MMEM / 256, 4096 / 256, G, (G >= 96 && bx >= 64 && bx < 96) ? bx - 64 : (G >= 96 ? 32 : bx));
            pg8::EpiMemKV E{ssq + NZ_MEM, PARL(l, PAR_CQN), PARL(l, PAR_CKN), (bf16_t*)(WSG + WS_KC) + (size_t)l * MMEM * DM, (bf16_t*)(WSG + WS_VT) + (size_t)l * MMEM * DM, ssq + Z_KC + l * 2048};
            pg8::gemm_phase<pg8::EpiMemKV, pg8::Order, true, true>(lds, g, S, E);
        }
        GRID_BAR(); PHASE_FENCE(); STAMP(5 + 13 * l);
#ifndef NO_CONV
        {
            const float* cw = PARL(l, PAR_CONVW); const float* cb = PARL(l, PAR_CONVB); const float* lg = PARL(l, PAR_LNG); const float* lb = PARL(l, PAR_LNB);
            const int c0 = 2 * tid;
            LAS unsigned* abuf = (LAS unsigned*)lds;
            LAS float* red = (LAS float*)(lds + 62 * 2048);
            float w0[31], w1[31];
#pragma unroll
            for (int k = 0; k < 31; ++k) { w0[k] = cw[k * 1024 + c0]; w1[k] = cw[k * 1024 + c0 + 1]; }
            const float b0 = cb[c0], b1 = cb[c0 + 1], g0 = lg[c0], g1 = lg[c0 + 1], e0 = lb[c0], e1 = lb[c0 + 1];
            for (int tile = bx; tile < M / 32; tile += G) {
                const int t0 = tile * 32, tl0 = t0 % SEQ;
                __syncthreads();
#pragma unroll
                for (int hb = 0; hb < 2; ++hb) {
                    u32x4 v[8];
#pragma unroll
                    for (int i = 0; i < 8; ++i) { const int idx = tid + 512 * (hb * 8 + i), rr = idx >> 7, cc = idx & 127; const bool valid = (idx < 62 * 128) && (tl0 - 30 + rr) >= 0;
                        v[i] = (u32x4){0u, 0u, 0u, 0u}; if (valid) v[i] = *(const u32x4*)(AGLU + (size_t)(t0 - 30 + rr) * 1024 + cc * 8); }
#pragma unroll
                    for (int i = 0; i < 8; ++i) { const int idx = tid + 512 * (hb * 8 + i), rr = idx >> 7, cc = idx & 127;
                        if (idx < 62 * 128) *(LAS u32x4*)(lds + rr * 2048 + cc * 16) = v[i]; }
                }
                __syncthreads();
#pragma unroll 1
                for (int half = 0; half < 2; ++half) {
                    float y0[16], y1[16];
#pragma unroll
                    for (int tt = 0; tt < 16; ++tt) { y0[tt] = b0; y1[tt] = b1; }
                    const LAS unsigned* ab = abuf + half * 16 * 512 + tid;
#pragma unroll
                    for (int rr = 0; rr < 46; ++rr) { const unsigned av = ab[rr * 512]; const float a0 = bf_lo(av), a1 = bf_hi(av);
#pragma unroll
                        for (int tt = 0; tt < 16; ++tt) { const int k = rr - tt; if (k >= 0 && k <= 30) { y0[tt] += a0 * w0[k]; y1[tt] += a1 * w1[k]; } } }
                    float ms = 0.f, mq = 0.f;
#pragma unroll
                    for (int tt = 0; tt < 16; ++tt) { float sv = y0[tt] + y1[tt], qv = y0[tt] * y0[tt] + y1[tt] * y1[tt]; sv = wave_sum(sv); qv = wave_sum(qv);
                        ms = (lane == tt) ? sv : ms; mq = (lane == tt) ? qv : mq; }
                    if (lane < 16) { red[(wave * 16 + lane) * 2] = ms; red[(wave * 16 + lane) * 2 + 1] = mq; }
                    __syncthreads();
                    float mu_v, rs_v;
                    { const int tq = lane & 15; float sv = 0.f, qv = 0.f;
#pragma unroll
                      for (int w = 0; w < 8; ++w) { sv += red[(w * 16 + tq) * 2]; qv += red[(w * 16 + tq) * 2 + 1]; }
                      mu_v = sv * (1.0f / 1024.0f); rs_v = __builtin_amdgcn_rsqf(qv * (1.0f / 1024.0f) - mu_v * mu_v + EPS); }
#pragma unroll
                    for (int tt = 0; tt < 16; ++tt) {
                        const float mu = __int_as_float(__builtin_amdgcn_readlane(__float_as_int(mu_v), tt)), rstd = __int_as_float(__builtin_amdgcn_readlane(__float_as_int(rs_v), tt));
                        const float v0 = (y0[tt] - mu) * rstd * g0 + e0, v1 = (y1[tt] - mu) * rstd * g1 + e1;
                        *(unsigned*)(MIX + (size_t)(t0 + half * 16 + tt) * DM + c0) = cvt_pk_bf16(siluf_(v0), siluf_(v1)); }
                    __syncthreads();
                }
            }
            __syncthreads();
        }
#endif
        STAMP(29 + 3 * l);
        {
            pg8::Gemm g{CQ, WPTR(l, W_QB), 768, 768, 768, 0}; pg8::Order S; S.init(M / 256, 1536 / 256, G, bx);
            pg8::EpiPlain E{QF, 1536, ssq + Z_CQ + l * M, 1.0f / 768.0f};
            pg8::gemm_phase<pg8::EpiPlain, pg8::Order, true, true>(lds, g, S, E);
        }
        STAMP(30 + 3 * l);
        {
            pg8::Gemm g{CKV, WPTR(l, W_KVB), 256, 256, 256, 0}; pg8::Order S; S.init(M / 256, 2048 / 256, G, bx);
            pg8::EpiPlain E{KVR, 2048, ssq + Z_CKV + l * M, 1.0f / 256.0f};
            pg8::gemm_phase<pg8::EpiPlain, pg8::Order, true, true>(lds, g, S, E);
        }
        GRID_BAR(); PHASE_FENCE(); STAMP(6 + 13 * l);
#ifndef NO_PREP
        {
            const float* gq = PARL(l, PAR_QN); const float* gk = PARL(l, PAR_KN); const int* pos = (const int*)(PAR + PAR_POS);
            const float gq0 = gq[2 * lane], gq1 = gq[2 * lane + 1], gqr = gq[128 + lane], gk0 = gk[2 * lane], gk1 = gk[2 * lane + 1], gkr = gk[128 + lane];
            const float invf = INV_FREQ[lane & 31];
            for (int row0 = gw; row0 < M; row0 += 2 * NGW) {
                const int rowv[2] = {row0, (row0 + NGW < M) ? row0 + NGW : row0};
                unsigned kpe_w[2], kw[2][8], qw[2][8], qrw[2][8]; int posv[2];
#pragma unroll
                for (int t = 0; t < 2; ++t) { const int row = rowv[t]; const bf16_t* kvp = KVR + (size_t)row * 2048 + 2 * lane; const bf16_t* qp = QF + (size_t)row * 1536;
                    kpe_w[t] = *(const unsigned*)(KPE + (size_t)row * 64 + (lane & ~1)); posv[t] = pos[row];
#pragma unroll
                    for (int h = 0; h < 8; ++h) { kw[t][h] = *(const unsigned*)(kvp + h * 256); qw[t][h] = *(const unsigned*)(qp + h * 192 + 2 * lane); qrw[t][h] = *(const unsigned*)(qp + h * 192 + 128 + (lane & ~1)); } }
                unsigned ko[2][8], qo[2][8]; unsigned kro[2][8], qro[2][8];
#pragma unroll
                for (int t = 0; t < 2; ++t) {
                    const float ang = (float)posv[t] * invf;
                    double rev = (double)ang * 0.15915494309189535; rev -= __builtin_rint(rev);
                    const float frv = (float)rev; const float cs = __builtin_amdgcn_cosf(frv), sn = __builtin_amdgcn_sinf(frv);
                    const float sgn = (lane < 32) ? -sn : sn;
                    const float kraw = (lane & 1) ? bf_hi(kpe_w[t]) : bf_lo(kpe_w[t]); const float ssq_pe = wave_sum(kraw * kraw);
                    const float ky = kraw * gkr; const float kpart = __shfl_xor(ky, 32); const float krot = ky * cs + kpart * sgn;
#pragma unroll
                    for (int h = 0; h < 8; ++h) {
                        const float v0 = bf_lo(kw[t][h]), v1 = bf_hi(kw[t][h]);
                        const float sq = wave_sum(v0 * v0 + v1 * v1) + ssq_pe; const float rs = rstd_of(sq, 1.0f / 192.0f);
                        ko[t][h] = cvt_pk_bf16(v0 * rs * gk0, v1 * rs * gk1); kro[t][h] = cvt_pk_bf16(krot * rs, 0.f);
                    }
#pragma unroll
                    for (int h = 0; h < 8; ++h) {
                        const float v0 = bf_lo(qw[t][h]), v1 = bf_hi(qw[t][h]); const float vr = (lane & 1) ? bf_hi(qrw[t][h]) : bf_lo(qrw[t][h]);
                        const float sq = wave_sum(v0 * v0 + v1 * v1 + vr * vr); const float rs = rstd_of(sq, 1.0f / 192.0f) * QSCALE;
                        const float qy = vr * gqr; const float qpart = __shfl_xor(qy, 32); const float qrot = qy * cs + qpart * sgn;
                        qo[t][h] = cvt_pk_bf16(v0 * rs * gq0, v1 * rs * gq1); qro[t][h] = cvt_pk_bf16(qrot * rs, 0.f);
                    }
                }
#pragma unroll
                for (int t = 0; t < 2; ++t) { if (t == 1 && rowv[1] == rowv[0]) break; bf16_t* qp0 = QF + (size_t)rowv[t] * 1536; bf16_t* kp0 = KF + (size_t)rowv[t] * 1536;
#pragma unroll
                    for (int h = 0; h < 8; ++h) { *(unsigned*)(kp0 + h * 192 + 2 * lane) = ko[t][h]; kp0[h * 192 + 128 + lane] = (bf16_t)(kro[t][h] & 0xffffu);
                        *(unsigned*)(qp0 + h * 192 + 2 * lane) = qo[t][h]; qp0[h * 192 + 128 + lane] = (bf16_t)(qro[t][h] & 0xffffu); } }
            }
        }
#endif
        GRID_BAR(); PHASE_FENCE(); STAMP(7 + 13 * l);
#ifndef NO_ATTN
        {
            for (int it = vcu; it < 256; it += G) { const int bh = it >> 4, s = it & 15;
                mla::attn_unit(bh >> 3, bh & 7, 31 - s, QF, KF, KVR, MIX, (char*)lds_raw);
                mla::attn_unit(bh >> 3, bh & 7, s, QF, KF, KVR, MIX, (char*)lds_raw); }
        }
#endif
        GRID_BAR(); PHASE_FENCE(); STAMP(8 + 13 * l);
        {
            pg8::Gemm g{MIX, WPTR(l, W_OUT), DM, DM, DM, 0}; pg8::Order S; S.init(M / 256, DM / 256, G, bx);
            pg8::EpiResid E{(float*)(GAS float*)out, XB, ssq + ssqx(4 * l + 2), 1.0f, 0};
            pg8::gemm_phase<pg8::EpiResid, pg8::Order, true, true>(lds, g, S, E);
        }
        GRID_BAR(); PHASE_FENCE(); STAMP(9 + 13 * l);
        {
            pg8::Gemm g{XB, WPTR(l, W_CQ), DM, DM, DM, 0}; pg8::Order S; S.init(M / 256, DM / 256, G, bx);
            pg8::EpiCq E{QC, ssq + ssqx(4 * l + 2), ssq + Z_QC + l * 4 * M};
            pg8::gemm_phase<pg8::EpiCq, pg8::Order, true, true>(lds, g, S, E);
        }
        GRID_BAR(); PHASE_FENCE(); STAMP(10 + 13 * l);
        {
            pg8::Gemm g{QC, (bf16_t*)(WSG + WS_KC) + (size_t)l * MMEM * DM, DM, DM, 512, 1};
            pg8::EpiSoftmax E{PC, ssq + Z_QC + l * 4 * M, ssq + Z_KC + l * 2048};
            for (int u = bx; u < 256; u += G) { pg8::SingleOrder S; S.u0.pm = u >> 2; S.u0.pn = u & 3;
                pg8::gemm_phase<pg8::EpiSoftmax, pg8::SingleOrder, false, true>(lds, g, S, E); }
        }
        GRID_BAR(); PHASE_FENCE(); STAMP(11 + 13 * l);
        {
            pg8::Gemm g{PC, (bf16_t*)(WSG + WS_VT) + (size_t)l * MMEM * DM, 1024, 256, 256, 2}; pg8::Order S; S.init(M / 256, 8, G, bx);
            pg8::EpiPlain E{OC, DM, nullptr, 1.0f};
            pg8::gemm_phase<pg8::EpiPlain, pg8::Order, true, true>(lds, g, S, E);
        }
        GRID_BAR(); PHASE_FENCE(); STAMP(12 + 13 * l);
        {
            pg8::Gemm g{OC, WPTR(l, W_CO), DM, DM, DM, 0}; pg8::Order S; S.init(M / 256, DM / 256, G, bx);
            pg8::EpiResid E{(float*)(GAS float*)out, XB, ssq + ssqx(4 * l + 3), 1.0f, 0};
            pg8::gemm_phase<pg8::EpiResid, pg8::Order, true, true>(lds, g, S, E);
        }
        GRID_BAR(); PHASE_FENCE(); STAMP(13 + 13 * l);
        {
            pg8::Gemm g{XB, WPTR(l, W_GU2), DM, DM, DM, 0}; pg8::Order S; S.init(M / 256, 2 * DFF / 256, G, bx);
            pg8::EpiGateUp E{HB, ssq + ssqx(4 * l + 3)};
            pg8::gemm_phase<pg8::EpiGateUp, pg8::Order, true, true>(lds, g, S, E);
        }
        GRID_BAR(); PHASE_FENCE(); STAMP(14 + 13 * l);
        {
            pg8::Gemm g{HB, WPTR(l, W_D2), DFF, DFF, DFF, 0}; pg8::Order S; S.init(M / 256, DM / 256, G, bx);
            pg8::EpiResid E{(float*)(GAS float*)out, XB, ssq + ssqx(4 * l + 4), 0.5f, l == 0 ? 0 : 1};
            pg8::gemm_phase<pg8::EpiResid, pg8::Order, true, true>(lds, g, S, E);
        }
#ifdef TPROBE
        GRID_BAR(); PHASE_FENCE(); STAMP(15 + 13 * l);
#else
        if (l == 0) { GRID_BAR(); PHASE_FENCE(); }
#endif
    }
#ifdef TPROBE
    {
        __syncthreads();
        const LAS unsigned long long* ts = (const LAS unsigned long long*)(lds + 140 * 1024);
        const float T = (float)(ts[28] - ts[0]);
        float sel = (float)(ts[TSEL_HI] - ts[TSEL_LO]);
        if (TSEL_BOTH) sel += (float)(ts[TSEL_HI + 13] - ts[TSEL_LO + 13]);
        const float dlt = 0.012f * sqrtf(sel / T);
        float* o = (float*)(GAS float*)out;
        for (int i = bx * 512 + tid; i < (1 << 22); i += G * 512) o[i] += (i & 1) ? dlt : -dlt;
    }
#endif
}

extern "C" void kernel_launch(void* const* d_in, const int* in_sizes, int n_in, void* d_out, int out_size, void* d_ws, size_t ws_size, hipStream_t stream) {
    static int grid = 0;
    if (grid == 0) {
        if (n_in != 32 || out_size != M * DM || ws_size < WS_END) { fprintf(stderr, "kernel_launch: unexpected shapes: n_in %d out %d ws %zu (need %zu)\n", n_in, out_size, ws_size, (size_t)WS_END); grid = -1; return; }
        int dev = 0, cus = 0, per_cu = 0;
        if (hipGetDevice(&dev) != hipSuccess || hipDeviceGetAttribute(&cus, hipDeviceAttributeMultiprocessorCount, dev) != hipSuccess) { grid = -1; return; }
        if (hipFuncSetAttribute((const void*)fwd_megakernel, hipFuncAttributeMaxDynamicSharedMemorySize, LDS_BYTES) != hipSuccess) { fprintf(stderr, "hipFuncSetAttribute failed\n"); grid = -1; return; }
        if (hipOccupancyMaxActiveBlocksPerMultiprocessor(&per_cu, (const void*)fwd_megakernel, 512, LDS_BYTES) != hipSuccess || per_cu < 1) { fprintf(stderr, "occupancy query failed (%d)\n", per_cu); grid = -1; return; }
        grid = cus * per_cu;
    }
    if (grid < 0) return;
    if (hipMemsetAsync((char*)d_ws + WS_CTL, 0, CTL_BYTES, stream) != hipSuccess) { fprintf(stderr, "memset failed\n"); return; }
    Args a{};
    for (int i = 0; i < 32; ++i) a.in[i] = d_in[i];
    a.out = (float*)d_out; a.ws = (unsigned char*)d_ws;
    void* args[] = {&a};
    hipError_t e = hipLaunchCooperativeKernel((const void*)fwd_megakernel, dim3(grid), dim3(512), args, LDS_BYTES, stream);
    if (e != hipSuccess) fprintf(stderr, "cooperative launch failed: %s (grid %d)\n", hipGetErrorString(e), grid);
}
```

```cpp
#include <hip/hip_runtime.h>
#include <hip/hip_cooperative_groups.h>
#include <cstdio>
#include <cstdint>
namespace cg = cooperative_groups;

#define LAS __attribute__((address_space(3)))
typedef unsigned short bf16_t;
typedef short bf16x8 __attribute__((ext_vector_type(8)));
typedef short s16x4 __attribute__((ext_vector_type(4)));
typedef float f32x4 __attribute__((ext_vector_type(4)));
typedef float f32x16 __attribute__((ext_vector_type(16)));
typedef unsigned u32x4 __attribute__((ext_vector_type(4)));
typedef unsigned u32x2 __attribute__((ext_vector_type(2)));
typedef unsigned long long ssq_t;

constexpr int M = 16384, DM = 2048, DFF = 5632, SEQ = 8192, NMEM = 256, MMEM = 512;
constexpr int NIN = 3136, NINP = 3328;
constexpr float EPS = 1e-6f;
constexpr float LOG2E = 1.4426950408889634f;
constexpr float QSCALE = 0.07216878364870322f * LOG2E;
constexpr float XSCALE = 0.04419417382415922f * LOG2E;

constexpr size_t MiB = 1u << 20;
constexpr size_t WS_SSQ = 760 * MiB;
constexpr size_t WS_W = 2 * MiB, LW = 190 * MiB;
constexpr size_t W_GU1 = 0, W_D1 = 44 * MiB, W_IN = 66 * MiB, W_QB = 79 * MiB, W_KVB = 82 * MiB, W_OUT = 83 * MiB, W_CQ = 91 * MiB,
                 W_CKV = 99 * MiB, W_CO = 115 * MiB, W_GU2 = 123 * MiB, W_D2 = 167 * MiB;
constexpr size_t WS_XB = 382 * MiB, WS_H = 446 * MiB, WS_KVR = 622 * MiB, WS_MIX = 686 * MiB, WS_MEMB = 750 * MiB, WS_KC = 752 * MiB,
                 WS_VT = 756 * MiB, WS_END = 764 * MiB;
constexpr size_t H_AGLU = 0, H_CQ = 32 * MiB, H_CKV = 56 * MiB, H_KPE = 64 * MiB, H_QF = 66 * MiB, H_KF = 114 * MiB;
constexpr size_t H_QC = 0, H_PC = 64 * MiB, H_OC = 96 * MiB;
constexpr int Z_CQ = 8 * M, Z_CKV = 10 * M, Z_QC = 12 * M, Z_KC = 20 * M, ZERO_COUNT = 20 * M + 4096, NZ_X0 = ZERO_COUNT, NZ_MEM = ZERO_COUNT + M;
__device__ __forceinline__ int ssqx(int s) { return s == 0 ? NZ_X0 : (s - 1) * M; }

constexpr size_t WS_PAR = 1536 * 1024;
constexpr int PAR_POS = 0, PAR_L0 = 16384, PAR_LS = 36864, PAR_CONVW = 0, PAR_CONVB = 31744, PAR_LNG = 32768, PAR_LNB = 33792, PAR_QN = 34816, PAR_KN = 35008, PAR_CQN = 35200, PAR_CKN = 35712;
constexpr size_t WS_CTL = 1900 * 1024, CTL_BYTES = 16384;
constexpr int LDS_BYTES = 147456;

__device__ __forceinline__ unsigned cvt_pk_bf16(float lo, float hi) { unsigned r; asm volatile("v_cvt_pk_bf16_f32 %0, %1, %2" : "=v"(r) : "v"(lo), "v"(hi)); return r; }
__device__ __forceinline__ float bf_lo(unsigned w) { return __uint_as_float(w << 16); }
__device__ __forceinline__ float bf_hi(unsigned w) { return __uint_as_float(w & 0xffff0000u); }
__device__ __forceinline__ float bf2f(bf16_t v) { return __uint_as_float(((unsigned)v) << 16); }
__device__ __forceinline__ float wave_sum(float v) {
    v += __int_as_float(__builtin_amdgcn_update_dpp(0, __float_as_int(v), 0xB1, 0xF, 0xF, true));
    v += __int_as_float(__builtin_amdgcn_update_dpp(0, __float_as_int(v), 0x4E, 0xF, 0xF, true));
    v += __int_as_float(__builtin_amdgcn_update_dpp(0, __float_as_int(v), 0x141, 0xF, 0xF, true));
    v += __int_as_float(__builtin_amdgcn_update_dpp(0, __float_as_int(v), 0x140, 0xF, 0xF, true));
    const float a = __int_as_float(__builtin_amdgcn_readlane(__float_as_int(v), 0)), b = __int_as_float(__builtin_amdgcn_readlane(__float_as_int(v), 16));
    const float c = __int_as_float(__builtin_amdgcn_readlane(__float_as_int(v), 32)), d = __int_as_float(__builtin_amdgcn_readlane(__float_as_int(v), 48));
    return (a + b) + (c + d);
}
__device__ __forceinline__ float rstd_of(float ssq, float inv_n) { return __builtin_amdgcn_rsqf(ssq * inv_n + EPS); }
__device__ __forceinline__ float rstd_of(ssq_t v, float inv_n) { return __builtin_amdgcn_rsqf(((float)v * 2.3283064365386963e-10f) * inv_n + EPS); }
__device__ __forceinline__ ssq_t ssq_fix(float s) { return (ssq_t)(s * 4294967296.0f); }
__device__ __forceinline__ float sigmoidf_(float g) { return __builtin_amdgcn_rcpf(1.0f + __builtin_amdgcn_exp2f(-g * LOG2E)); }
__device__ __forceinline__ float siluf_(float g) { return g * sigmoidf_(g); }
#define LDS_WAIT() asm volatile("s_waitcnt lgkmcnt(0)" ::: "memory")
#define VM_WAIT() asm volatile("s_waitcnt vmcnt(0)" ::: "memory")

namespace pg8 {
constexpr int BM = 256, BK = 64, HALF = 128, HTB = HALF * BK * 2, STAGE_BYTES = 8 * HTB, NXCD = 8, WGM = 4;
__host__ __device__ __forceinline__ int lds_byte(int r, int c) { const int st = (r >> 4) * 2 + (c >> 5), rr = r & 15, cc = c & 31, ob = rr * 64 + cc * 2; return st * 1024 + (ob ^ (((ob >> 9) & 1) << 5)); }
__host__ __device__ __forceinline__ void stage_rc(int b, int& R, int& C) { const int st = b / 1024, sb = b % 1024, swz = sb ^ (((sb >> 9) & 1) << 5); R = (st >> 1) * 16 + swz / 64; C = (st & 1) * 32 + (swz % 64) / 2; }
__host__ __device__ __forceinline__ int perm32(int rho) { const int n = rho >> 4, i = rho & 15; return 8 * (i >> 2) + 4 * n + (i & 3); }

struct Unit { int pm, pn; };
struct Gemm { const bf16_t* A; const bf16_t* Bt; int lda, ldb, K, mode; };
__device__ __forceinline__ void unit_ptrs(const Gemm& g, const Unit& u, const char*& pa, const char*& pb) {
    size_t ao, bo;
    if (g.mode == 0) { ao = (size_t)u.pm * 256 * g.lda; bo = (size_t)u.pn * 256 * g.ldb; }
    else if (g.mode == 1) { ao = (size_t)u.pm * 256 * g.lda + (size_t)u.pn * 512; bo = (size_t)(u.pm >> 5) * 256 * g.ldb + (size_t)u.pn * 512; }
    else { const int h = u.pn >> 1, dt = u.pn & 1; ao = (size_t)u.pm * 256 * g.lda + (size_t)h * 256; bo = (size_t)((((u.pm >> 5) * 4 + h) * 512) + dt * 256) * g.ldb; }
    pa = (const char*)g.A + ao * 2; pb = (const char*)g.Bt + bo * 2;
}
struct Order {
    int nM, nN, nwg, G, c;
    __device__ __forceinline__ void init(int nM_, int nN_, int G_, int c_) { nM = nM_; nN = nN_; nwg = nM * nN; G = G_; c = c_; }
    __device__ __forceinline__ bool next(int i, Unit& u) const {
        const long L = (long)i * G + c; if (L >= nwg) return false;
        int wgid = (int)L; { const int q = nwg / NXCD, r = nwg % NXCD, xcd = wgid % NXCD, off = wgid / NXCD; wgid = (xcd < r ? xcd * (q + 1) : r * (q + 1) + (xcd - r) * q) + off; }
        const int nig = WGM * nN, gid = wgid / nig, fm = gid * WGM, gsz = (nM - fm) < WGM ? (nM - fm) : WGM;
        u.pm = fm + ((wgid % nig) % gsz); u.pn = (wgid % nig) / gsz; return true;
    }
};
struct SingleOrder {
    Unit u0;
    __device__ __forceinline__ bool next(int i, Unit& u) const { if (i != 0) return false; u = u0; return true; }
};

template <class Epi, class Sched, bool ALIGN_EPI, bool SP2>
__device__ __forceinline__ void gemm_phase(LAS unsigned char* lds, const Gemm g, const Sched& S, const Epi& E) {
    int tid_ = threadIdx.x; asm volatile("" : "+v"(tid_));
    const int tid = tid_, wid = __builtin_amdgcn_readfirstlane(tid >> 6), lane = tid & 63, wr = wid >> 2, wc = wid & 3, fr = lane & 15, fq = lane >> 4;
    const int K = g.K, nt = K / BK;
    unsigned voffA[2], voffB[2];
#pragma unroll
    for (int i = 0; i < 2; ++i) { int R, C; stage_rc(tid * 16 + i * 8192, R, C); const int Rb = Epi::PERM ? ((R & ~31) + perm32(R & 31)) : R;
        voffA[i] = (unsigned)(R * g.lda + C) * 2u; voffB[i] = (unsigned)(Rb * g.ldb + C) * 2u; }
    const size_t kstep = (size_t)(BK * 2);
    const size_t hstepA = (size_t)HALF * g.lda * 2, hstepB = (size_t)HALF * g.ldb * 2;
    const unsigned ldsw = (unsigned)wid * 1024u;
    const int aoff = lds_byte(wr * 64 + fr, fq * 8), boff = lds_byte(wc * 32 + fr, fq * 8);
#define PG8_SA(b, h) (((b) * 2 + (h)) * HTB)
#define PG8_SB(b, h) ((4 + (b) * 2 + (h)) * HTB)
#define PG8_STAGE(bufoff, gbase, voff) do { _Pragma("unroll") for (int _i = 0; _i < 2; ++_i) \
        __builtin_amdgcn_global_load_lds((const unsigned*)((const char*)(gbase) + (voff)[_i]), (LAS unsigned*)(lds + (bufoff) + ldsw + _i * 8192), 16, 0, 0); } while (0)
#define PG8_LDA(dst, b, h) do { _Pragma("unroll") for (int m = 0; m < 4; ++m) _Pragma("unroll") for (int k = 0; k < 2; ++k) dst[m][k] = *(const LAS bf16x8*)(lds + PG8_SA(b, h) + aoff + m * 2048 + k * 1024); } while (0)
#define PG8_LDB(dst, b, h) do { _Pragma("unroll") for (int n = 0; n < 2; ++n) _Pragma("unroll") for (int k = 0; k < 2; ++k) dst[n][k] = *(const LAS bf16x8*)(lds + PG8_SB(b, h) + boff + n * 2048 + k * 1024); } while (0)
#define PG8_MMA(ai, bj, At, Bt) do { __builtin_amdgcn_s_setprio(1); _Pragma("unroll") for (int m = 0; m < 4; ++m) _Pragma("unroll") for (int n = 0; n < 2; ++n) _Pragma("unroll") for (int k = 0; k < 2; ++k) \
        acc[ai][bj][m][n] = __builtin_amdgcn_mfma_f32_16x16x32_bf16(Bt[n][k], At[m][k], acc[ai][bj][m][n], 0, 0, 0); __builtin_amdgcn_s_setprio(0); } while (0)
#define PG8_WAIT_V(n) asm volatile("s_waitcnt vmcnt(" #n ")" ::: "memory")
#define PG8_WAIT_L(n) asm volatile("s_waitcnt lgkmcnt(" #n ")" ::: "memory")
#define PG8_BAR __builtin_amdgcn_s_barrier()
#define PG8_SCHED __builtin_amdgcn_sched_barrier(0)
    Unit cur, nxt; int ui = 0;
    if (!S.next(0, cur)) return;
    f32x4 acc[2][2][4][2];
#pragma unroll
    for (int a = 0; a < 2; ++a)
#pragma unroll
        for (int b = 0; b < 2; ++b)
#pragma unroll
            for (int m = 0; m < 4; ++m)
#pragma unroll
                for (int n = 0; n < 2; ++n) acc[a][b][m][n] = (f32x4){0.f, 0.f, 0.f, 0.f};
    bf16x8 At[4][2], B0[2][2], B1[2][2];
    const char* cA; const char* cB; unit_ptrs(g, cur, cA, cB);
    if constexpr (SP2) {
        PG8_STAGE(PG8_SB(0, 0), cB, voffB); PG8_STAGE(PG8_SB(0, 1), cB + hstepB, voffB); PG8_STAGE(PG8_SA(0, 0), cA, voffA); PG8_STAGE(PG8_SA(0, 1), cA + hstepA, voffA);
        if (wr == 1) PG8_BAR;
        PG8_WAIT_V(2); PG8_BAR;
        PG8_STAGE(PG8_SB(1, 0), cB + kstep, voffB); PG8_STAGE(PG8_SA(1, 0), cA + kstep, voffA); PG8_STAGE(PG8_SB(1, 1), cB + hstepB + kstep, voffB);
        PG8_WAIT_V(6); PG8_BAR;
    } else {
        PG8_STAGE(PG8_SB(0, 0), cB, voffB); PG8_STAGE(PG8_SA(0, 0), cA, voffA); PG8_STAGE(PG8_SB(0, 1), cB + hstepB, voffB); PG8_STAGE(PG8_SA(0, 1), cA + hstepA, voffA);
        if (wr == 1) PG8_BAR;
        PG8_WAIT_V(4); PG8_BAR;
        PG8_STAGE(PG8_SB(1, 0), cB + kstep, voffB); PG8_STAGE(PG8_SA(1, 0), cA + kstep, voffA); PG8_STAGE(PG8_SB(1, 1), cB + hstepB + kstep, voffB);
        PG8_WAIT_V(6); PG8_BAR;
    }
    for (;;) {
        const bool has_next = S.next(ui + 1, nxt);
        const char* nA = cA; const char* nB = cB; if (has_next) unit_ptrs(g, nxt, nA, nB);
        for (int t = 0; t < nt; t += 2) {
            const bool last = (t == nt - 2);
            const char* a1 = cA + (size_t)(t + 1) * kstep;
            const char* a2 = last ? nA : cA + (size_t)(t + 2) * kstep; const char* b2 = last ? nB : cB + (size_t)(t + 2) * kstep;
            const char* a3 = a2 + kstep; const char* b3 = b2 + kstep;
            if constexpr (SP2) {
            PG8_LDB(B0, 0, 0); PG8_LDB(B1, 0, 1); PG8_SCHED; PG8_LDA(At, 0, 0); PG8_STAGE(PG8_SA(1, 1), a1 + hstepA, voffA);
            PG8_WAIT_V(8); PG8_WAIT_L(0); PG8_BAR; PG8_MMA(0, 0, At, B0); PG8_MMA(0, 1, At, B1); PG8_BAR; PG8_SCHED;
            PG8_LDA(At, 0, 1); PG8_STAGE(PG8_SB(0, 0), b2, voffB); PG8_STAGE(PG8_SB(0, 1), b2 + hstepB, voffB); PG8_STAGE(PG8_SA(0, 0), a2, voffA);
            PG8_WAIT_V(8); PG8_WAIT_L(0); PG8_BAR; PG8_MMA(1, 0, At, B0); PG8_MMA(1, 1, At, B1); PG8_BAR; PG8_SCHED;
            PG8_LDB(B0, 1, 0); PG8_LDB(B1, 1, 1); PG8_SCHED; PG8_LDA(At, 1, 0); PG8_STAGE(PG8_SA(0, 1), a2 + hstepA, voffA);
            PG8_WAIT_V(8); PG8_WAIT_L(0); PG8_BAR; PG8_MMA(0, 0, At, B0); PG8_MMA(0, 1, At, B1); PG8_BAR; PG8_SCHED;
            PG8_LDA(At, 1, 1); PG8_STAGE(PG8_SB(1, 0), b3, voffB); PG8_STAGE(PG8_SB(1, 1), b3 + hstepB, voffB); PG8_STAGE(PG8_SA(1, 0), a3, voffA);
            PG8_WAIT_V(8); PG8_WAIT_L(0); PG8_BAR; PG8_MMA(1, 0, At, B0); PG8_MMA(1, 1, At, B1); PG8_BAR; PG8_SCHED;
            } else {
            PG8_LDB(B0, 0, 0); PG8_SCHED; PG8_LDA(At, 0, 0); PG8_STAGE(PG8_SA(1, 1), a1 + hstepA, voffA);
            PG8_WAIT_L(8); PG8_BAR; PG8_WAIT_L(0); PG8_MMA(0, 0, At, B0); PG8_BAR; PG8_SCHED;
            PG8_LDB(B1, 0, 1); PG8_STAGE(PG8_SB(0, 0), b2, voffB);
            PG8_BAR; PG8_WAIT_L(0); PG8_MMA(0, 1, At, B1); PG8_BAR;
            PG8_LDA(At, 0, 1); PG8_STAGE(PG8_SA(0, 0), a2, voffA);
            PG8_BAR; PG8_WAIT_L(0); PG8_MMA(1, 0, At, B0); PG8_BAR; PG8_SCHED;
            PG8_STAGE(PG8_SB(0, 1), b2 + hstepB, voffB);
            PG8_WAIT_V(6); PG8_BAR; PG8_MMA(1, 1, At, B1); PG8_BAR;
            PG8_LDB(B0, 1, 0); PG8_SCHED; PG8_LDA(At, 1, 0); PG8_STAGE(PG8_SA(0, 1), a2 + hstepA, voffA);
            PG8_WAIT_L(8); PG8_BAR; PG8_WAIT_L(0); PG8_MMA(0, 0, At, B0); PG8_BAR; PG8_SCHED;
            PG8_LDB(B1, 1, 1); PG8_STAGE(PG8_SB(1, 0), b3, voffB);
            PG8_BAR; PG8_WAIT_L(0); PG8_MMA(0, 1, At, B1); PG8_BAR;
            PG8_LDA(At, 1, 1); PG8_STAGE(PG8_SA(1, 0), a3, voffA);
            PG8_BAR; PG8_WAIT_L(0); PG8_MMA(1, 0, At, B0); PG8_BAR; PG8_SCHED;
            PG8_STAGE(PG8_SB(1, 1), b3 + hstepB, voffB);
            PG8_WAIT_V(6); PG8_BAR; PG8_MMA(1, 1, At, B1); PG8_BAR;
            }
        }
        if constexpr (ALIGN_EPI) { if (wr == 0) PG8_BAR; }
        if constexpr (!Epi::AFTER_DRAIN) { E(acc, cur, wr, wc, fr, fq); }
        if (!has_next) break;
#pragma unroll
        for (int a = 0; a < 2; ++a)
#pragma unroll
            for (int b = 0; b < 2; ++b)
#pragma unroll
                for (int m = 0; m < 4; ++m)
#pragma unroll
                    for (int n = 0; n < 2; ++n) acc[a][b][m][n] = (f32x4){0.f, 0.f, 0.f, 0.f};
        cur = nxt; cA = nA; cB = nB; ++ui;
        if constexpr (ALIGN_EPI) { if (wr == 1) PG8_BAR; }
    }
    PG8_WAIT_V(0);
    if constexpr (!ALIGN_EPI) { if (wr == 0) PG8_BAR; }
    PG8_BAR;
    if constexpr (Epi::AFTER_DRAIN) { E.fused(acc, cur, wr, wc, fr, fq, lds, wid, lane); }
#undef PG8_SA
#undef PG8_SB
#undef PG8_STAGE
#undef PG8_LDA
#undef PG8_LDB
#undef PG8_MMA
#undef PG8_WAIT_V
#undef PG8_WAIT_L
#undef PG8_BAR
#undef PG8_SCHED
}

typedef f32x4 Acc[2][2][4][2];
#define PACK8(v0, v1) (u32x4){cvt_pk_bf16((v0)[0], (v0)[1]), cvt_pk_bf16((v0)[2], (v0)[3]), cvt_pk_bf16((v1)[0], (v1)[1]), cvt_pk_bf16((v1)[2], (v1)[3])}

struct EpiGateUp {
    static constexpr bool PERM = true, AFTER_DRAIN = false;
    bf16_t* H; const ssq_t* ssq;
    __device__ __forceinline__ void operator()(const Acc& acc, const Unit& u, int wr, int wc, int fr, int fq) const {
        const int row0 = u.pm * BM + wr * 64 + fr, col0 = u.pn * 128 + wc * 32 + 8 * fq;
        ssq_t rsv[2][4];
#pragma unroll
        for (int ai = 0; ai < 2; ++ai)
#pragma unroll
            for (int m = 0; m < 4; ++m) rsv[ai][m] = ssq[row0 + ai * HALF + m * 16];
#pragma unroll
        for (int ai = 0; ai < 2; ++ai)
#pragma unroll
            for (int m = 0; m < 4; ++m) { const int r = row0 + ai * HALF + m * 16; const float rs = rstd_of(rsv[ai][m], 1.0f / 2048.0f);
                f32x4 o[2];
#pragma unroll
                for (int n = 0; n < 2; ++n)
#pragma unroll
                    for (int i = 0; i < 4; ++i) { const float gt = acc[ai][0][m][n][i] * rs, up = acc[ai][1][m][n][i] * rs; o[n][i] = siluf_(gt) * up; }
                *(u32x4*)(H + (size_t)r * DFF + col0) = PACK8(o[0], o[1]); }
    }
};
struct EpiResid {
    static constexpr bool PERM = true, AFTER_DRAIN = false;
    float* xdst; bf16_t* xb; ssq_t* ssq_out; float alpha; int final_out;
    __device__ __forceinline__ void operator()(const Acc& acc, const Unit& u, int wr, int wc, int fr, int fq) const {
        const int row0 = u.pm * BM + wr * 64 + fr, col0 = u.pn * BM + wc * 32 + 8 * fq;
        u32x4 xv[2][2];
#define RES_LOAD(buf, g_) do { const size_t off_ = (size_t)(row0 + ((g_) >> 2) * HALF + ((g_) & 3) * 16) * DM + col0; \
        _Pragma("unroll") for (int bj = 0; bj < 2; ++bj) xv[buf][bj] = *(const u32x4*)(xb + off_ + bj * HALF); } while (0)
        RES_LOAD(0, 0);
#pragma unroll
        for (int g_ = 0; g_ < 8; ++g_) { const int ai = g_ >> 2, m = g_ & 3, r = row0 + ai * HALF + m * 16; const size_t off = (size_t)r * DM + col0; float s = 0.f;
            if (g_ + 1 < 8) RES_LOAD((g_ + 1) & 1, g_ + 1);
#pragma unroll
            for (int bj = 0; bj < 2; ++bj) { const u32x4 w = xv[g_ & 1][bj];
                const f32x4 x0 = (f32x4){bf_lo(w.x), bf_hi(w.x), bf_lo(w.y), bf_hi(w.y)}, x1 = (f32x4){bf_lo(w.z), bf_hi(w.z), bf_lo(w.w), bf_hi(w.w)};
                const f32x4 o0 = x0 + acc[ai][bj][m][0] * alpha, o1 = x1 + acc[ai][bj][m][1] * alpha;
                if (final_out) { *(f32x4*)(xdst + off + bj * HALF) = o0; *(f32x4*)(xdst + off + bj * HALF + 4) = o1; }
                else { s += (o0[0] * o0[0] + o0[1] * o0[1]) + (o0[2] * o0[2] + o0[3] * o0[3]) + (o1[0] * o1[0] + o1[1] * o1[1]) + (o1[2] * o1[2] + o1[3] * o1[3]);
                       *(u32x4*)(xb + off + bj * HALF) = PACK8(o0, o1); } }
            if (!final_out) { s += __shfl_xor(s, 16); s += __shfl_xor(s, 32); if (fq == 0) atomicAdd(ssq_out + r, ssq_fix(s)); } }
#undef RES_LOAD
    }
};
struct EpiWin {
    static constexpr bool PERM = true, AFTER_DRAIN = false;
    const ssq_t* ssq; bf16_t* AGLU; bf16_t* CQ; bf16_t* CKV; bf16_t* KPE; ssq_t* ssq_cq; ssq_t* ssq_ckv;
    __device__ __forceinline__ void operator()(const Acc& acc, const Unit& u, int wr, int wc, int fr, int fq) const {
        const int row0 = u.pm * BM + wr * 64 + fr, cw = wc * 32 + 8 * fq, pn = u.pn;
        ssq_t rsv[2][4];
#pragma unroll
        for (int ai = 0; ai < 2; ++ai)
#pragma unroll
            for (int m = 0; m < 4; ++m) rsv[ai][m] = ssq[row0 + ai * HALF + m * 16];
#pragma unroll
        for (int ai = 0; ai < 2; ++ai)
#pragma unroll
            for (int m = 0; m < 4; ++m) { const int r = row0 + ai * HALF + m * 16; const float rs = rstd_of(rsv[ai][m], 1.0f / 2048.0f);
                if (pn < 8) {
                    f32x4 o[2];
#pragma unroll
                    for (int n = 0; n < 2; ++n)
#pragma unroll
                        for (int i = 0; i < 4; ++i) o[n][i] = (acc[ai][0][m][n][i] * rs) * sigmoidf_(acc[ai][1][m][n][i] * rs);
                    *(u32x4*)(AGLU + (size_t)r * 1024 + pn * 128 + cw) = PACK8(o[0], o[1]);
                } else if (pn < 12) {
                    float s = 0.f;
#pragma unroll
                    for (int bj = 0; bj < 2; ++bj) { const f32x4 v0 = acc[ai][bj][m][0] * rs, v1 = acc[ai][bj][m][1] * rs;
                        s += (v0[0] * v0[0] + v0[1] * v0[1]) + (v0[2] * v0[2] + v0[3] * v0[3]) + (v1[0] * v1[0] + v1[1] * v1[1]) + (v1[2] * v1[2] + v1[3] * v1[3]);
                        if (pn < 11) *(u32x4*)(CQ + (size_t)r * 768 + (pn - 8) * 256 + bj * HALF + cw) = PACK8(v0, v1);
                        else *(u32x4*)(CKV + (size_t)r * 256 + bj * HALF + cw) = PACK8(v0, v1); }
                    s += __shfl_xor(s, 16); s += __shfl_xor(s, 32);
                    if (fq == 0) atomicAdd((pn < 11 ? ssq_cq : ssq_ckv) + r, ssq_fix(s));
                } else {
                    if (wc < 2) { const f32x4 v0 = acc[ai][0][m][0] * rs, v1 = acc[ai][0][m][1] * rs; *(u32x4*)(KPE + (size_t)r * 64 + cw) = PACK8(v0, v1); }
                } }
    }
};
struct EpiPlain {
    static constexpr bool PERM = true, AFTER_DRAIN = false;
    bf16_t* O; int ldc; const ssq_t* ssq; float inv_n;
    __device__ __forceinline__ void operator()(const Acc& acc, const Unit& u, int wr, int wc, int fr, int fq) const {
        const int row0 = u.pm * BM + wr * 64 + fr, col0 = u.pn * BM + wc * 32 + 8 * fq;
        ssq_t rsv[2][4];
#pragma unroll
        for (int ai = 0; ai < 2; ++ai)
#pragma unroll
            for (int m = 0; m < 4; ++m) rsv[ai][m] = ssq ? ssq[row0 + ai * HALF + m * 16] : (ssq_t)0;
#pragma unroll
        for (int ai = 0; ai < 2; ++ai)
#pragma unroll
            for (int m = 0; m < 4; ++m) { const int r = row0 + ai * HALF + m * 16; const float rs = ssq ? rstd_of(rsv[ai][m], inv_n) : 1.0f;
#pragma unroll
                for (int bj = 0; bj < 2; ++bj) { const f32x4 v0 = acc[ai][bj][m][0] * rs, v1 = acc[ai][bj][m][1] * rs; *(u32x4*)(O + (size_t)r * ldc + col0 + bj * HALF) = PACK8(v0, v1); } }
    }
};
struct EpiCq {
    static constexpr bool PERM = true, AFTER_DRAIN = false;
    bf16_t* QC; const ssq_t* ssq; ssq_t* ssq_qc;
    __device__ __forceinline__ void operator()(const Acc& acc, const Unit& u, int wr, int wc, int fr, int fq) const {
        const int row0 = u.pm * BM + wr * 64 + fr, col0 = u.pn * BM + wc * 32 + 8 * fq, head = u.pn >> 1;
        ssq_t rsv[2][4];
#pragma unroll
        for (int ai = 0; ai < 2; ++ai)
#pragma unroll
            for (int m = 0; m < 4; ++m) rsv[ai][m] = ssq[row0 + ai * HALF + m * 16];
#pragma unroll
        for (int ai = 0; ai < 2; ++ai)
#pragma unroll
            for (int m = 0; m < 4; ++m) { const int r = row0 + ai * HALF + m * 16; const float rs = rstd_of(rsv[ai][m], 1.0f / 2048.0f); float s = 0.f;
#pragma unroll
                for (int bj = 0; bj < 2; ++bj) { const f32x4 v0 = acc[ai][bj][m][0] * rs, v1 = acc[ai][bj][m][1] * rs;
                    s += (v0[0] * v0[0] + v0[1] * v0[1]) + (v0[2] * v0[2] + v0[3] * v0[3]) + (v1[0] * v1[0] + v1[1] * v1[1]) + (v1[2] * v1[2] + v1[3] * v1[3]);
                    *(u32x4*)(QC + (size_t)r * DM + col0 + bj * HALF) = PACK8(v0, v1); }
                s += __shfl_xor(s, 16); s += __shfl_xor(s, 32);
                if (fq == 0) atomicAdd(ssq_qc + r * 4 + head, ssq_fix(s)); }
    }
};
struct EpiMemKV {
    static constexpr bool PERM = true, AFTER_DRAIN = false;
    const ssq_t* ssq_mem; const float* gq; const float* gk; bf16_t* KC; bf16_t* VT; ssq_t* ssq_kc;
    __device__ __forceinline__ void operator()(const Acc& acc, const Unit& u, int wr, int wc, int fr, int fq) const {
        const int row0 = u.pm * BM + wr * 64 + fr, pn = u.pn;
#pragma unroll
        for (int ai = 0; ai < 2; ++ai)
#pragma unroll
            for (int m = 0; m < 4; ++m) { const int r = row0 + ai * HALF + m * 16; const float rs = rstd_of(ssq_mem[r], 1.0f / 2048.0f);
                if (pn < 8) { float s = 0.f;
#pragma unroll
                    for (int bj = 0; bj < 2; ++bj) { const int col = pn * BM + bj * HALF + wc * 32 + 8 * fq, d = col & 511; f32x4 v[2];
#pragma unroll
                        for (int n = 0; n < 2; ++n) { v[n] = acc[ai][bj][m][n] * rs; s += (v[n][0] * v[n][0] + v[n][1] * v[n][1]) + (v[n][2] * v[n][2] + v[n][3] * v[n][3]);
                            const f32x4 a = *(const f32x4*)(gq + d + 4 * n), b = *(const f32x4*)(gk + d + 4 * n); v[n] = v[n] * a * b; }
                        *(u32x4*)(KC + (size_t)r * DM + col) = PACK8(v[0], v[1]); }
                    s += __shfl_xor(s, 16); s += __shfl_xor(s, 32);
                    if (fq == 0) atomicAdd(ssq_kc + r * 4 + (pn >> 1), ssq_fix(s));
                } else {
                    const int b = r >> 8, mm = r & 255;
#pragma unroll
                    for (int bj = 0; bj < 2; ++bj)
#pragma unroll
                        for (int n = 0; n < 2; ++n)
#pragma unroll
                            for (int i = 0; i < 4; ++i) { const int col = (pn - 8) * BM + bj * HALF + wc * 32 + 8 * fq + 4 * n + i, h = col >> 9, d = col & 511;
                                VT[((size_t)((b * 4 + h) * 512 + d)) * 256 + mm] = (bf16_t)(cvt_pk_bf16(acc[ai][bj][m][n][i] * rs, 0.f) & 0xffffu); }
                } }
    }
};
struct EpiSoftmax {
    static constexpr bool PERM = true, AFTER_DRAIN = true;
    bf16_t* P; const ssq_t* ssq_qc; const ssq_t* ssq_kc;
    __device__ __forceinline__ void fused(Acc& acc, const Unit& u, int wr, int wc, int fr, int fq, LAS unsigned char* lds, int wid, int lane) const {
        LAS float* X = (LAS float*)lds; LAS float* Y = X + 1024;
        const int h = u.pn, b = u.pm >> 5;
        f32x4 rk[2][2];
#pragma unroll
        for (int bj = 0; bj < 2; ++bj)
#pragma unroll
            for (int n = 0; n < 2; ++n)
#pragma unroll
                for (int i = 0; i < 4; ++i) { const int mm = bj * HALF + wc * 32 + 8 * fq + 4 * n + i; rk[bj][n][i] = rstd_of(ssq_kc[(b * 256 + mm) * 4 + h], 1.0f / 512.0f) * XSCALE; }
#pragma unroll
        for (int ai = 0; ai < 2; ++ai)
#pragma unroll
            for (int m = 0; m < 4; ++m) { const int rl = ai * HALF + wr * 64 + m * 16 + fr, r = u.pm * BM + rl; const float rq = rstd_of(ssq_qc[r * 4 + h], 1.0f / 512.0f); float mx = -3.0e38f;
#pragma unroll
                for (int bj = 0; bj < 2; ++bj)
#pragma unroll
                    for (int n = 0; n < 2; ++n) { const f32x4 v = acc[ai][bj][m][n] * rk[bj][n] * rq; acc[ai][bj][m][n] = v; mx = fmaxf(fmaxf(mx, fmaxf(v[0], v[1])), fmaxf(v[2], v[3])); }
                mx = fmaxf(mx, __shfl_xor(mx, 16)); mx = fmaxf(mx, __shfl_xor(mx, 32));
                if (fq == 0) X[rl * 4 + wc] = mx; }
        LDS_WAIT(); __builtin_amdgcn_s_barrier(); asm volatile("" ::: "memory");
#pragma unroll
        for (int ai = 0; ai < 2; ++ai)
#pragma unroll
            for (int m = 0; m < 4; ++m) { const int rl = ai * HALF + wr * 64 + m * 16 + fr; const float mx = fmaxf(fmaxf(X[rl * 4 + 0], X[rl * 4 + 1]), fmaxf(X[rl * 4 + 2], X[rl * 4 + 3])); float s = 0.f;
#pragma unroll
                for (int bj = 0; bj < 2; ++bj)
#pragma unroll
                    for (int n = 0; n < 2; ++n) { f32x4 v = acc[ai][bj][m][n];
#pragma unroll
                        for (int i = 0; i < 4; ++i) { v[i] = __builtin_amdgcn_exp2f(v[i] - mx); s += v[i]; }
                        acc[ai][bj][m][n] = v; }
                s += __shfl_xor(s, 16); s += __shfl_xor(s, 32);
                if (fq == 0) Y[rl * 4 + wc] = s; }
        LDS_WAIT(); __builtin_amdgcn_s_barrier(); asm volatile("" ::: "memory");
#pragma unroll
        for (int ai = 0; ai < 2; ++ai)
#pragma unroll
            for (int m = 0; m < 4; ++m) { const int rl = ai * HALF + wr * 64 + m * 16 + fr, r = u.pm * BM + rl; const float inv = 1.0f / ((Y[rl * 4 + 0] + Y[rl * 4 + 1]) + (Y[rl * 4 + 2] + Y[rl * 4 + 3]));
#pragma unroll
                for (int bj = 0; bj < 2; ++bj) { const f32x4 v0 = acc[ai][bj][m][0] * inv, v1 = acc[ai][bj][m][1] * inv;
                    *(u32x4*)(P + (size_t)r * 1024 + h * 256 + bj * HALF + wc * 32 + 8 * fq) = PACK8(v0, v1); } }
        LDS_WAIT(); __builtin_amdgcn_s_barrier(); asm volatile("" ::: "memory");
    }
};
}

namespace mla {
constexpr int NW = 8, QBLK = 32, KVBLK = 64, LDQ = 1536, LDK = 1536, LDV = 2048, LDO = 2048;
constexpr int SHM_V = 64 * 128 * 2, SHM_K = 64 * 192 * 2, SHM_ATTN = 4 * SHM_V + 3 * SHM_K + NW * 64 * 4;
constexpr float THRL = 8.0f;
#define KSWZ(row, colB) ((row) * 384 + ((colB) ^ ((((row) >> 1) & 7) << 4)))
#define SBAR() __builtin_amdgcn_sched_barrier(0)
__device__ __forceinline__ int crow(int r, int hi) { return (r & 3) + 8 * (r >> 2) + 4 * hi; }
__device__ __forceinline__ int v_st(int k, int c) { const int kk = (k & ~0xC) | ((k & 4) << 1) | ((k & 8) >> 1); return ((kk >> 3) * 4 + (c >> 5)) * 512 + ((kk & 7) * 32 + (c & 31)) * 2; }
__device__ __forceinline__ int v_rd_base(int lane) { return ((lane & 3) << 3) | (((lane >> 2) & 3) << 6) | (((lane >> 4) & 1) << 5) | (((lane >> 5) & 1) << 8); }
constexpr int v_rd_off(int d0, int ks, int half) { return d0 * 512 + ks * 4096 + half * 2048; }
template <int OFF> __device__ __forceinline__ s16x4 tr_read(int vb) {
    s16x4 r; asm volatile("ds_read_b64_tr_b16 %0, %1 offset:%2" : "=&v"(r) : "v"(vb), "i"(OFF) : "memory"); return r;
}
template <int D0> __device__ __forceinline__ void pv_one(f32x16& od, int vb, bf16x8 pa0, bf16x8 pa1, bf16x8 pa2, bf16x8 pa3) {
    const s16x4 l0 = tr_read<v_rd_off(D0, 0, 0)>(vb), h0 = tr_read<v_rd_off(D0, 0, 1)>(vb), l1 = tr_read<v_rd_off(D0, 1, 0)>(vb), h1 = tr_read<v_rd_off(D0, 1, 1)>(vb);
    const s16x4 l2 = tr_read<v_rd_off(D0, 2, 0)>(vb), h2 = tr_read<v_rd_off(D0, 2, 1)>(vb), l3 = tr_read<v_rd_off(D0, 3, 0)>(vb), h3 = tr_read<v_rd_off(D0, 3, 1)>(vb);
    asm volatile("s_waitcnt lgkmcnt(0)" ::: "memory"); SBAR();
#define PK(L, H) (bf16x8){L[0], L[1], L[2], L[3], H[0], H[1], H[2], H[3]}
    od = __builtin_amdgcn_mfma_f32_32x32x16_bf16(pa0, PK(l0, h0), od, 0, 0, 0);
    od = __builtin_amdgcn_mfma_f32_32x32x16_bf16(pa1, PK(l1, h1), od, 0, 0, 0);
    od = __builtin_amdgcn_mfma_f32_32x32x16_bf16(pa2, PK(l2, h2), od, 0, 0, 0);
    od = __builtin_amdgcn_mfma_f32_32x32x16_bf16(pa3, PK(l3, h3), od, 0, 0, 0);
#undef PK
}
__device__ __forceinline__ void sm_pv(f32x16& p0, f32x16& p1, float& m_reg, float& l_reg, f32x16 (&o)[4], float* al_l, int vb, int r32, int hi, bool first) {
    float pmax = p0[0];
#pragma unroll
    for (int r = 1; r < 16; ++r) pmax = fmaxf(pmax, p0[r]);
#pragma unroll
    for (int r = 0; r < 16; ++r) pmax = fmaxf(pmax, p1[r]);
    { auto rr = __builtin_amdgcn_permlane32_swap(__float_as_uint(pmax), __float_as_uint(pmax), false, false);
      pmax = fmaxf(__uint_as_float(rr[0]), __uint_as_float(rr[1])); }
    if (first) {
        m_reg += pmax;
#pragma unroll
        for (int r = 0; r < 16; ++r) { p0[r] -= pmax; p1[r] -= pmax; }
    } else if (!__all(pmax <= THRL)) {
        const float dl = fmaxf(pmax, 0.f); const float alpha = __builtin_amdgcn_exp2f(-dl); m_reg += dl; l_reg *= alpha;
#pragma unroll
        for (int r = 0; r < 16; ++r) { p0[r] -= dl; p1[r] -= dl; }
        if (hi == 0) al_l[r32] = alpha;
        LDS_WAIT();
#pragma unroll
        for (int d = 0; d < 4; ++d)
#pragma unroll
            for (int r = 0; r < 16; ++r) o[d][r] *= al_l[crow(r, hi)];
    }
#pragma unroll
    for (int r = 0; r < 16; ++r) { p0[r] = __builtin_amdgcn_exp2f(p0[r]); p1[r] = __builtin_amdgcn_exp2f(p1[r]); }
    typedef float f32x2v __attribute__((ext_vector_type(2)));
    f32x2v ps2 = (f32x2v){0.f, 0.f};
#pragma unroll
    for (int r = 0; r < 16; r += 2) { ps2 += (f32x2v){p0[r], p0[r + 1]}; ps2 += (f32x2v){p1[r], p1[r + 1]}; }
    float ps = ps2.x + ps2.y;
    { auto rr = __builtin_amdgcn_permlane32_swap(__float_as_uint(ps), __float_as_uint(ps), false, false);
      ps = __uint_as_float(rr[0]) + __uint_as_float(rr[1]); }
    l_reg += ps;
    bf16x8 pa0, pa1, pa2, pa3;
#define PK4(P, BASE, OUT) do { unsigned a0 = cvt_pk_bf16(P[BASE + 0], P[BASE + 1]), a1 = cvt_pk_bf16(P[BASE + 2], P[BASE + 3]);   \
    unsigned b0 = cvt_pk_bf16(P[BASE + 4], P[BASE + 5]), b1 = cvt_pk_bf16(P[BASE + 6], P[BASE + 7]);                              \
    auto r0 = __builtin_amdgcn_permlane32_swap(a0, b0, false, false); auto r1 = __builtin_amdgcn_permlane32_swap(a1, b1, false, false); \
    u32x4 w = {r0[0], r1[0], r0[1], r1[1]}; OUT = *reinterpret_cast<bf16x8*>(&w); } while (0)
    PK4(p0, 0, pa0); PK4(p0, 8, pa1); PK4(p1, 0, pa2); PK4(p1, 8, pa3);
#undef PK4
    typedef short v4i16_t __attribute__((ext_vector_type(4)));
    const LAS char* vp = (const LAS char*)(__UINTPTR_TYPE__)(unsigned)vb;
    const bf16x8 pa[4] = {pa0, pa1, pa2, pa3};
#pragma unroll
    for (int ks = 0; ks < 4; ++ks)
#pragma unroll
        for (int d0 = 0; d0 < 4; ++d0) {
            const s16x4 lo = __builtin_bit_cast(s16x4, __builtin_amdgcn_ds_read_tr16_b64_v4i16((LAS v4i16_t*)(vp + v_rd_off(d0, ks, 0))));
            const s16x4 hh = __builtin_bit_cast(s16x4, __builtin_amdgcn_ds_read_tr16_b64_v4i16((LAS v4i16_t*)(vp + v_rd_off(d0, ks, 1))));
            o[d0] = __builtin_amdgcn_mfma_f32_32x32x16_bf16(pa[ks], (bf16x8){lo[0], lo[1], lo[2], lo[3], hh[0], hh[1], hh[2], hh[3]}, o[d0], 0, 0, 0);
        }
}
__device__ __forceinline__ void attn_unit(int b, int h, int qb, const bf16_t* __restrict__ QF, const bf16_t* __restrict__ KF, const bf16_t* __restrict__ KVR, bf16_t* __restrict__ MIX, char* lds) {
    int tid_ = threadIdx.x; asm volatile("" : "+v"(tid_));
    const int tid = tid_, wid = __builtin_amdgcn_readfirstlane(tid >> 6), lane = tid & 63, r32 = lane & 31, hi = lane >> 5;
    char* V_lds = lds; char* K_lds = lds + 4 * SHM_V;
    float* ws = (float*)(lds + 4 * SHM_V + 3 * SHM_K) + wid * 64; float* li_l = ws; float* al_l = ws + 32;
    const long rowbase = (long)b * SEQ; const int q0 = qb * 256;
    float m_reg = 0.f, l_reg = 0.f; f32x16 o[4] = {}; bf16x8 qr[12];
    const bf16_t* Qw = QF + (rowbase + q0 + wid * QBLK + r32) * LDQ + h * 192 + hi * 8;
#pragma unroll
    for (int d0 = 0; d0 < 12; ++d0) qr[d0] = *reinterpret_cast<const bf16x8*>(Qw + d0 * 16);
    VM_WAIT();
#pragma unroll
    for (int d0 = 0; d0 < 12; ++d0) asm volatile("" : "+v"(qr[d0]));
    const bf16_t* Kh = KF + rowbase * LDK + h * 192; const bf16_t* Vh = KVR + rowbase * LDV + h * 256 + 128;
    int koff[3], voff[2];
#pragma unroll
    for (int i = 0; i < 3; ++i) { const int S = (wid * 3 + i) * 64 + lane, row = S / 24, ch = (S % 24) ^ ((row >> 1) & 7); koff[i] = row * LDK + ch * 8; }
#pragma unroll
    for (int i = 0; i < 2; ++i) { const int S = (wid * 2 + i) * 64 + lane, sub = S >> 5, within = S & 31, kk = ((sub >> 2) << 3) | (within >> 2), c = ((sub & 3) << 5) | ((within & 3) << 3);
        const int k = (kk & ~0xC) | ((kk & 4) << 1) | ((kk & 8) >> 1); voff[i] = k * LDV + c; }
    const int vb0 = (int)(uintptr_t)V_lds + v_rd_base(lane);
    LAS unsigned char* Kl = (LAS unsigned char*)(unsigned)(uintptr_t)K_lds; LAS unsigned char* Vl = (LAS unsigned char*)(unsigned)(uintptr_t)V_lds;
#define DMA_TILE(t_, kbuf_, vbo_) do { const bf16_t* kg_ = Kh + (long)(t_) * KVBLK * LDK; const bf16_t* vg_ = Vh + (long)(t_) * KVBLK * LDV; \
    _Pragma("unroll") for (int i = 0; i < 3; ++i) __builtin_amdgcn_global_load_lds((const unsigned*)(kg_ + koff[i]), (LAS unsigned*)(Kl + (kbuf_) * SHM_K + (wid * 3 + i) * 1024), 16, 0, 0); \
    _Pragma("unroll") for (int i = 0; i < 2; ++i) __builtin_amdgcn_global_load_lds((const unsigned*)(vg_ + voff[i]), (LAS unsigned*)(Vl + (vbo_) + (wid * 2 + i) * 1024), 16, 0, 0); } while (0)
#define WAIT_BAR(N) do { asm volatile("s_waitcnt vmcnt(" #N ") lgkmcnt(0)" ::: "memory"); __builtin_amdgcn_s_barrier(); asm volatile("" ::: "memory"); } while (0)
    const int NT = 4 * qb + 4, tmax = 4 * qb + (wid >> 1);
    const bool late = wid >= 4;
    f32x16 p0 = {}, p1 = {};
    int vprev = 3 * SHM_V, vcur = 0, vnext = SHM_V, vnn = 2 * SHM_V;
    int kcur = 0, knext = 1, knn = 2;
    DMA_TILE(0, 0, 0); DMA_TILE(1, 1, SHM_V);
    WAIT_BAR(5);
    for (int j = 0; j < NT; ++j) {
        if (j + 2 < NT) DMA_TILE(j + 2, knn, vnn);
        if (late && j >= 1 && j - 1 <= tmax) sm_pv(p0, p1, m_reg, l_reg, o, al_l, vb0 + vprev, r32, hi, j == 1);
        if (j <= tmax) {
#pragma unroll
            for (int r = 0; r < 16; ++r) { p0[r] = -m_reg; p1[r] = -m_reg; }
            const char* Ks = K_lds + kcur * SHM_K;
            bf16x8 ka[4], kb[4];
#define KRD(dst, D0B) do { _Pragma("unroll") for (int i = 0; i < 2; ++i) { const int cb = (((D0B) + i) * 16 + hi * 8) * 2; \
    dst[2 * i] = *reinterpret_cast<const bf16x8*>(Ks + KSWZ(r32, cb)); dst[2 * i + 1] = *reinterpret_cast<const bf16x8*>(Ks + KSWZ(32 + r32, cb)); } } while (0)
#define KMM(src, D0B) do { _Pragma("unroll") for (int i = 0; i < 2; ++i) { p0 = __builtin_amdgcn_mfma_f32_32x32x16_bf16(src[2 * i], qr[(D0B) + i], p0, 0, 0, 0); \
    p1 = __builtin_amdgcn_mfma_f32_32x32x16_bf16(src[2 * i + 1], qr[(D0B) + i], p1, 0, 0, 0); } } while (0)
            KRD(ka, 0); KRD(kb, 2); SBAR();
            KMM(ka, 0); SBAR(); KRD(ka, 4); SBAR(); KMM(kb, 2); SBAR(); KRD(kb, 6); SBAR();
            KMM(ka, 4); SBAR(); KRD(ka, 8); SBAR(); KMM(kb, 6); SBAR(); KRD(kb, 10); SBAR();
            KMM(ka, 8); SBAR(); KMM(kb, 10);
#undef KRD
#undef KMM
        }
        if (!late && j <= tmax) sm_pv(p0, p1, m_reg, l_reg, o, al_l, vb0 + vcur, r32, hi, j == 0);
        if (j + 2 < NT) WAIT_BAR(5); else WAIT_BAR(0);
        { const int t = vprev; vprev = vcur; vcur = vnext; vnext = vnn; vnn = t; }
        { const int t = kcur; kcur = knext; knext = knn; knn = t; }
    }
    if (late && NT - 1 <= tmax) sm_pv(p0, p1, m_reg, l_reg, o, al_l, vb0 + vprev, r32, hi, false);
    if (hi == 0) li_l[r32] = l_reg;
    LDS_WAIT();
    float rli[16];
#pragma unroll
    for (int r = 0; r < 16; ++r) rli[r] = __builtin_amdgcn_rcpf(li_l[crow(r, hi)]);
    bf16_t* Ow = MIX + (rowbase + q0 + wid * QBLK) * LDO + 1024 + h * 128;
#pragma unroll
    for (int r = 0; r < 16; ++r) { const int orow = crow(r, hi);
#pragma unroll
        for (int d0 = 0; d0 < 4; ++d0) Ow[(long)orow * LDO + d0 * 32 + r32] = (bf16_t)(cvt_pk_bf16(o[d0][r] * rli[r], 0.f) & 0xffffu); }
    WAIT_BAR(0);
#undef DMA_TILE
#undef WAIT_BAR
}
#undef SBAR
}

struct Args { const void* in[32]; float* out; unsigned char* ws; };

__device__ const float INV_FREQ[32] = {
    1.000000000e+00f, 7.498942018e-01f, 5.623413324e-01f, 4.216965139e-01f, 3.162277639e-01f, 2.371373922e-01f, 1.778279394e-01f, 1.333521456e-01f,
    1.000000015e-01f, 7.498941571e-02f, 5.623412877e-02f, 4.216964915e-02f, 3.162277862e-02f, 2.371373586e-02f, 1.778279431e-02f, 1.333521493e-02f,
    9.999999776e-03f, 7.498942316e-03f, 5.623413250e-03f, 4.216964822e-03f, 3.162277862e-03f, 2.371373819e-03f, 1.778279431e-03f, 1.333521446e-03f,
    1.000000047e-03f, 7.498941850e-04f, 5.623413017e-04f, 4.216965463e-04f, 3.162277862e-04f, 2.371373848e-04f, 1.778279402e-04f, 1.333521504e-04f};

__device__ __forceinline__ void transpose_job(const float* W, int ldw, int K, int ncols, const float* gain, bf16_t* WT, int mode, int off,
                                              LAS float* T, int& base, int bx, int G, int tid) {
    const int nblk = (ncols + 127) >> 7, nitems = (K >> 7) * nblk;
    const int first = (bx + G - (base % G)) % G;
    f32x4 R[8];
#define TJ_LOAD(it_) do { const int kb_ = (it_) / nblk, nb_ = (it_) % nblk; \
    _Pragma("unroll") for (int i = 0; i < 8; ++i) { const int idx = tid + 512 * i, row = idx >> 5, n = nb_ * 128 + (idx & 31) * 4; \
        R[i] = (n < ncols) ? *(const f32x4*)(W + (size_t)(kb_ * 128 + row) * ldw + n) : (f32x4){0.f, 0.f, 0.f, 0.f}; } } while (0)
    if (first < nitems) TJ_LOAD(first);
    for (int it = first; it < nitems; it += G) {
        const int kb = it / nblk, nb = it % nblk;
        __syncthreads();
#pragma unroll
        for (int i = 0; i < 8; ++i) { const int idx = tid + 512 * i, row = idx >> 5, c4 = (idx & 31) * 4; const float gsc = gain ? gain[kb * 128 + row] : 1.0f;
            *(LAS f32x4*)(T + row * 128 + (c4 ^ (((row >> 3) & 7) << 2))) = R[i] * gsc; }
        if (it + G < nitems) TJ_LOAD(it + G);
        __syncthreads();
        const int c = tid & 15;
#pragma unroll
        for (int i = 0; i < 4; ++i) { const int nl = 4 * ((tid >> 6) + 8 * i) + ((tid >> 4) & 3), n = nb * 128 + nl; const LAS float* sp = T + (8 * c) * 128 + (nl ^ ((c & 7) << 2));
            u32x4 o; o.x = cvt_pk_bf16(sp[0 * 128], sp[1 * 128]); o.y = cvt_pk_bf16(sp[2 * 128], sp[3 * 128]); o.z = cvt_pk_bf16(sp[4 * 128], sp[5 * 128]); o.w = cvt_pk_bf16(sp[6 * 128], sp[7 * 128]);
            const int drow = (mode == 0) ? (n + off) : (((n >> 7) << 8) + (n & 127) + off);
            if (n < ncols) *(u32x4*)(WT + (size_t)drow * K + kb * 128 + 8 * c) = o; }
    }
#undef TJ_LOAD
    base += nitems;
}


#define XB_TMO      128
#define XB_XCNT(j)  (256  + 64 * (j))
#define XB_XSUB(j)  (1280 + 64 * (j))
#define XB_XGEN(j)  (2304 + 64 * (j))
#define XB_TOP      3328
#define XB_TOPGEN   3392
#define XCD_BAR_WORDS 3456
#define XB_SPIN_CAP (1u << 18)
__device__ __forceinline__ unsigned xb_ld(unsigned* p)              { return __hip_atomic_load(p, __ATOMIC_RELAXED, __HIP_MEMORY_SCOPE_AGENT); }
__device__ __forceinline__ unsigned xb_add(unsigned* p, unsigned v) { return __hip_atomic_fetch_add(p, v, __ATOMIC_RELAXED, __HIP_MEMORY_SCOPE_AGENT); }
__device__ __forceinline__ unsigned xb_xcc_id() { return (unsigned)__builtin_amdgcn_s_getreg((3 << 11) | 20) & 0xFu; }
#define XB_SPIN(cond, bar) do { unsigned _sp = 0; while (cond) { __builtin_amdgcn_s_sleep(1); \
    if ((++_sp & 255u) == 0u) { if (xb_ld(&(bar)[XB_TMO])) break; if (_sp > XB_SPIN_CAP) { atomicAdd(&(bar)[XB_TMO], 1u); break; } } } } while (0)
__device__ __forceinline__ void xcd_barrier_complete(unsigned* bar, unsigned x, unsigned& nloc, unsigned& nx) {
    const unsigned G = gridDim.x * gridDim.y * gridDim.z;
    unsigned sum, cnt, mine, sp = 0u;
    for (;;) {
        sum = 0u; cnt = 0u; mine = 0u;
#pragma unroll
        for (unsigned j = 0; j < 16; ++j) { const unsigned c = xb_ld(&bar[XB_XCNT(j)]); sum += c; cnt += (c > 0u) ? 1u : 0u; mine = (j == x) ? c : mine; }
        if (sum == G) break;
        __builtin_amdgcn_s_sleep(1);
        if ((++sp & 255u) == 0u) { if (xb_ld(&bar[XB_TMO])) break; if (sp > XB_SPIN_CAP) { atomicAdd(&bar[XB_TMO], 1u); break; } }
    }
    nloc = mine > 0u ? mine : 1u; nx = cnt > 0u ? cnt : 1u;
}
__device__ __forceinline__ void xcd_barrier(unsigned* bar, volatile LAS unsigned* st) {
    asm volatile("s_waitcnt vmcnt(0)" ::: "memory");
    __syncthreads();
    if (threadIdx.x == 0) {
        const unsigned x = xb_xcc_id();
        __builtin_amdgcn_s_waitcnt(0);
        unsigned nloc = st[0], nx = st[1];
        if (nloc == 0u) { xcd_barrier_complete(bar, x, nloc, nx); st[0] = nloc; st[1] = nx; }
        const unsigned old = xb_add(&bar[XB_XSUB(x)], 1u);
        const unsigned gen = old / nloc;
        if (old + 1u == (gen + 1u) * nloc) {
            __builtin_amdgcn_fence(__ATOMIC_RELEASE, "agent");
            asm volatile("s_waitcnt vmcnt(0)" ::: "memory");
            const unsigned og = xb_add(&bar[XB_TOP], 1u);
            const unsigned tg = og / nx;
            if (og + 1u == (tg + 1u) * nx) xb_add(&bar[XB_TOPGEN], 1u);
            else XB_SPIN(xb_ld(&bar[XB_TOPGEN]) == tg, bar);
            __builtin_amdgcn_fence(__ATOMIC_ACQUIRE, "agent");
            xb_add(&bar[XB_XGEN(x)], 1u);
            asm volatile("s_waitcnt vmcnt(0)" ::: "memory");
        } else {
            XB_SPIN(xb_ld(&bar[XB_XGEN(x)]) == gen, bar);
            __builtin_amdgcn_fence(__ATOMIC_ACQUIRE, "agent");
            asm volatile("s_waitcnt vmcnt(0)" ::: "memory");
        }
    }
    __syncthreads();
}

__global__ void __launch_bounds__(512, 2) fwd_megakernel(Args a) {
    extern __shared__ __attribute__((aligned(16))) unsigned char lds_raw[];
    cg::grid_group grid = cg::this_grid();
    LAS unsigned char* lds = (LAS unsigned char*)lds_raw;
    int tid = threadIdx.x;
#define lane (tid & 63)
#define wave (__builtin_amdgcn_readfirstlane(tid >> 6))
    int G = gridDim.x, bx = blockIdx.x;
#define vcu ((G % 8 == 0) ? (bx % 8) * (G / 8) + bx / 8 : bx)
#define NGW (G * 8)
#define gw (vcu * 8 + wave)
    unsigned char* ws = a.ws;
    const float* x_in = (const float*)a.in[0];
    float* out = a.out;
#define PHASE_FENCE() do { asm volatile("" : "+s"(ws)); asm volatile("" : "+s"(out)); asm volatile("" : "+v"(tid)); asm volatile("" : "+s"(G)); asm volatile("" : "+s"(bx)); } while (0)
#define GAS __attribute__((address_space(1)))
#define WSG ((GAS unsigned char*)ws)
#define ssq ((ssq_t*)(WSG + WS_SSQ))
#define PAR ((const float*)(WSG + WS_PAR))
#define XB ((bf16_t*)(WSG + WS_XB))
#define HB ((bf16_t*)(WSG + WS_H))
#define KVR ((bf16_t*)(WSG + WS_KVR))
#define MIX ((bf16_t*)(WSG + WS_MIX))
#define MEMB ((bf16_t*)(WSG + WS_MEMB))
#define AGLU ((bf16_t*)(WSG + WS_H + H_AGLU))
#define CQ ((bf16_t*)(WSG + WS_H + H_CQ))
#define CKV ((bf16_t*)(WSG + WS_H + H_CKV))
#define KPE ((bf16_t*)(WSG + WS_H + H_KPE))
#define QF ((bf16_t*)(WSG + WS_H + H_QF))
#define KF ((bf16_t*)(WSG + WS_H + H_KF))
#define QC ((bf16_t*)(WSG + WS_H + H_QC))
#define PC ((bf16_t*)(WSG + WS_H + H_PC))
#define OC ((bf16_t*)(WSG + WS_H + H_OC))
#define WPTR(l, o) ((bf16_t*)(WSG + WS_W + (size_t)(l) * LW + (o)))
#define PARL(l, o) (PAR + PAR_L0 + (l) * PAR_LS + (o))

#define GRID_BAR() xcd_barrier((unsigned*)(GAS unsigned*)(WSG + WS_CTL), (volatile LAS unsigned*)(lds + 139 * 1024))
    if (tid == 0) { ((volatile LAS unsigned*)(lds + 139 * 1024))[0] = 0u; ((volatile LAS unsigned*)(lds + 139 * 1024))[1] = 0u;
                    (void)xb_add((unsigned*)(GAS unsigned*)(WSG + WS_CTL) + XB_XCNT(xb_xcc_id()), 1u); }
    __syncthreads();
#ifdef TPROBE
#define STAMP(k) do { if (tid == 0) ((LAS unsigned long long*)(lds + 140 * 1024))[k] = __builtin_amdgcn_s_memrealtime(); } while (0)
#else
#define STAMP(k) do {} while (0)
#endif
    STAMP(0);
    {
        for (int i = bx * 512 + tid; i < ZERO_COUNT; i += G * 512) ssq[i] = (ssq_t)0;
        { float* par = (float*)(WSG + WS_PAR); const int gt = bx * 512 + tid, GT = G * 512;
          for (int i = gt; i < M; i += GT) ((int*)par)[PAR_POS + i] = ((const int*)a.in[2])[i];
          for (int i = gt; i < 2 * 31744; i += GT) { const int l = i / 31744, j = i % 31744; par[PAR_L0 + l * PAR_LS + PAR_CONVW + j] = ((const float*)a.in[9])[i]; }
          for (int i = gt; i < 2 * 1024; i += GT) { const int l = i >> 10, j = i & 1023; float* pl = par + PAR_L0 + l * PAR_LS;
              pl[PAR_CONVB + j] = ((const float*)a.in[10])[i]; pl[PAR_LNG + j] = ((const float*)a.in[11])[i]; pl[PAR_LNB + j] = ((const float*)a.in[12])[i];
              if (j < 512) { pl[PAR_CQN + j] = ((const float*)a.in[25])[l * 512 + j]; pl[PAR_CKN + j] = ((const float*)a.in[26])[l * 512 + j]; }
              if (j < 192) { pl[PAR_QN + j] = ((const float*)a.in[17])[l * 192 + j]; pl[PAR_KN + j] = ((const float*)a.in[18])[l * 192 + j]; } } }
        for (int l = 0; l < 2; ++l) { u32x4* p = (u32x4*)(WPTR(l, W_IN) + (size_t)NIN * DM); const int n16 = (NINP - NIN) * DM / 8;
            for (int i = bx * 512 + tid; i < n16; i += G * 512) p[i] = (u32x4){0u, 0u, 0u, 0u}; }
        for (int row = gw; row < M + MMEM; row += NGW) {
            const bool is_x = row < M; const int rr = is_x ? row : row - M;
            const float* src = (is_x ? x_in : (const float*)a.in[1]) + (size_t)rr * DM; bf16_t* dst = (is_x ? XB : MEMB) + (size_t)rr * DM;
            float s = 0.f;
#pragma unroll
            for (int j = 0; j < 8; ++j) { const f32x4 v = *(const f32x4*)(src + 256 * j + 4 * lane); s += (v[0] * v[0] + v[1] * v[1]) + (v[2] * v[2] + v[3] * v[3]);
                *(u32x2*)(dst + 256 * j + 4 * lane) = (u32x2){cvt_pk_bf16(v[0], v[1]), cvt_pk_bf16(v[2], v[3])}; }
            s = wave_sum(s);
            if (lane == 0) ssq[(is_x ? NZ_X0 : NZ_MEM) + rr] = ssq_fix(s);
        }
        LAS float* scr = (LAS float*)lds;
        int base = 0;
#pragma unroll 1
        for (int jb = 0; jb < 32; ++jb) {
            const int l = jb >> 4, j = jb & 15;
            const float* Wb = nullptr; const float* gb = nullptr; int ldw = DM, Kk = DM, nc = DM, mode = 0, off = 0, c0 = 0; size_t wo = 0, lstride = (size_t)DM * DM;
            switch (j) {
                case 0:  Wb = (const float*)a.in[4];  gb = (const float*)a.in[3];  ldw = DFF; Kk = DM;  nc = DFF;  mode = 1; off = 0;    wo = W_GU1; lstride = (size_t)DM * DFF; break;
                case 1:  Wb = (const float*)a.in[5];  gb = (const float*)a.in[3];  ldw = DFF; Kk = DM;  nc = DFF;  mode = 1; off = 128;  wo = W_GU1; lstride = (size_t)DM * DFF; break;
                case 2:  Wb = (const float*)a.in[6];  gb = nullptr; ldw = DM;  Kk = DFF; nc = DM;   mode = 0; off = 0;    wo = W_D1;  lstride = (size_t)DM * DFF; break;
                case 3:  Wb = (const float*)a.in[8];  gb = (const float*)a.in[7];  ldw = NIN; Kk = DM;  nc = 1024; mode = 1; off = 0;    wo = W_IN;  lstride = (size_t)DM * NIN; c0 = 0; break;
                case 4:  Wb = (const float*)a.in[8];  gb = (const float*)a.in[7];  ldw = NIN; Kk = DM;  nc = 1024; mode = 1; off = 128;  wo = W_IN;  lstride = (size_t)DM * NIN; c0 = 1024; break;
                case 5:  Wb = (const float*)a.in[8];  gb = (const float*)a.in[7];  ldw = NIN; Kk = DM;  nc = NIN - 2048; mode = 0; off = 2048; wo = W_IN; lstride = (size_t)DM * NIN; c0 = 2048; break;
                case 6:  Wb = (const float*)a.in[14]; gb = (const float*)a.in[13]; ldw = 1536; Kk = 768; nc = 1536; mode = 0; off = 0;   wo = W_QB;  lstride = (size_t)768 * 1536; break;
                case 7:  Wb = (const float*)a.in[16]; gb = (const float*)a.in[15]; ldw = 2048; Kk = 256; nc = 2048; mode = 0; off = 0;   wo = W_KVB; lstride = (size_t)256 * 2048; break;
                case 8:  Wb = (const float*)a.in[19]; gb = nullptr; wo = W_OUT; break;
                case 9:  Wb = (const float*)a.in[22]; gb = (const float*)a.in[20]; wo = W_CQ; break;
                case 10: Wb = (const float*)a.in[23]; gb = (const float*)a.in[21]; wo = W_CKV; break;
                case 11: Wb = (const float*)a.in[24]; gb = (const float*)a.in[21]; wo = W_CKV; off = 2048; break;
                case 12: Wb = (const float*)a.in[27]; gb = nullptr; wo = W_CO; break;
                case 13: Wb = (const float*)a.in[29]; gb = (const float*)a.in[28]; ldw = DFF; Kk = DM;  nc = DFF;  mode = 1; off = 0;    wo = W_GU2; lstride = (size_t)DM * DFF; break;
                case 14: Wb = (const float*)a.in[30]; gb = (const float*)a.in[28]; ldw = DFF; Kk = DM;  nc = DFF;  mode = 1; off = 128;  wo = W_GU2; lstride = (size_t)DM * DFF; break;
                default: Wb = (const float*)a.in[31]; gb = nullptr; ldw = DM;  Kk = DFF; nc = DM;   mode = 0; off = 0;    wo = W_D2;  lstride = (size_t)DM * DFF; break;
            }
            const float* Wp = Wb + (size_t)l * lstride + c0;
            const float* gp = gb ? gb + (size_t)l * Kk : nullptr;
            transpose_job(Wp, ldw, Kk, nc, gp, WPTR(l, wo), mode, off, scr, base, bx, G, tid);
        }
    }
    grid.sync(); PHASE_FENCE(); STAMP(1);

    STAMP(2);
#pragma unroll 1
    for (int l = 0; l < 2; ++l) {
        {
            pg8::Gemm g{XB, WPTR(l, W_GU1), DM, DM, DM, 0}; pg8::Order S; S.init(M / 256, 2 * DFF / 256, G, bx);
            pg8::EpiGateUp E{HB, ssq + ssqx(4 * l + 0)};
            pg8::gemm_phase<pg8::EpiGateUp, pg8::Order, true, true>(lds, g, S, E);
        }
        GRID_BAR(); PHASE_FENCE(); STAMP(3 + 13 * l);
        {
            pg8::Gemm g{HB, WPTR(l, W_D1), DFF, DFF, DFF, 0}; pg8::Order S; S.init(M / 256, DM / 256, G, bx);
            pg8::EpiResid E{(float*)(GAS float*)out, XB, ssq + ssqx(4 * l + 1), 0.5f, 0};
            pg8::gemm_phase<pg8::EpiResid, pg8::Order, true, true>(lds, g, S, E);
        }
        GRID_BAR(); PHASE_FENCE(); STAMP(4 + 13 * l);
        {
            pg8::Gemm g{XB, WPTR(l, W_IN), DM, DM, DM, 0}; pg8::Order S; S.init(M / 256, NINP / 256, G, bx);
            pg8::EpiWin E{ssq + ssqx(4 * l + 1), AGLU, CQ, CKV, KPE, ssq + Z_CQ + l * M, ssq + Z_CKV + l * M};
            pg8::gemm_phase<pg8::EpiWin, pg8::Order, true, true>(lds, g, S, E);
        }
        {
            pg8::Gemm g{MEMB, WPTR(l, W_CKV), DM, DM, DM, 0}; pg8::Order S; S.init(MMEM / 256, 4096 / 256, G, (G >= 96 && bx >= 64 && bx < 96) ? bx - 64 : (G >= 96 ? 32 : bx));
            pg8::EpiMemKV E{ssq + NZ_MEM, PARL(l, PAR_CQN), PARL(l, PAR_CKN), (bf16_t*)(WSG + WS_KC) + (size_t)l * MMEM * DM, (bf16_t*)(WSG + WS_VT) + (size_t)l * MMEM * DM, ssq + Z_KC + l * 2048};
            pg8::gemm_phase<pg8::EpiMemKV, pg8::Order, true, true>(lds, g, S, E);
        }
        GRID_BAR(); PHASE_FENCE(); STAMP(5 + 13 * l);
#ifndef NO_CONV
        {
            const float* cw = PARL(l, PAR_CONVW); const float* cb = PARL(l, PAR_CONVB); const float* lg = PARL(l, PAR_LNG); const float* lb = PARL(l, PAR_LNB);
            const int c0 = 2 * tid;
            LAS unsigned* abuf = (LAS unsigned*)lds;
            LAS float* red = (LAS float*)(lds + 62 * 2048);
            float w0[31], w1[31];
#pragma unroll
            for (int k = 0; k < 31; ++k) { w0[k] = cw[k * 1024 + c0]; w1[k] = cw[k * 1024 + c0 + 1]; }
            const float b0 = cb[c0], b1 = cb[c0 + 1], g0 = lg[c0], g1 = lg[c0 + 1], e0 = lb[c0], e1 = lb[c0 + 1];
            for (int tile = bx; tile < M / 32; tile += G) {
                const int t0 = tile * 32, tl0 = t0 % SEQ;
                __syncthreads();
#pragma unroll
                for (int hb = 0; hb < 2; ++hb) {
                    u32x4 v[8];
#pragma unroll
                    for (int i = 0; i < 8; ++i) { const int idx = tid + 512 * (hb * 8 + i), rr = idx >> 7, cc = idx & 127; const bool valid = (idx < 62 * 128) && (tl0 - 30 + rr) >= 0;
                        v[i] = (u32x4){0u, 0u, 0u, 0u}; if (valid) v[i] = *(const u32x4*)(AGLU + (size_t)(t0 - 30 + rr) * 1024 + cc * 8); }
#pragma unroll
                    for (int i = 0; i < 8; ++i) { const int idx = tid + 512 * (hb * 8 + i), rr = idx >> 7, cc = idx & 127;
                        if (idx < 62 * 128) *(LAS u32x4*)(lds + rr * 2048 + cc * 16) = v[i]; }
                }
                __syncthreads();
#pragma unroll 1
                for (int half = 0; half < 2; ++half) {
                    float y0[16], y1[16];
#pragma unroll
                    for (int tt = 0; tt < 16; ++tt) { y0[tt] = b0; y1[tt] = b1; }
                    const LAS unsigned* ab = abuf + half * 16 * 512 + tid;
#pragma unroll
                    for (int rr = 0; rr < 46; ++rr) { const unsigned av = ab[rr * 512]; const float a0 = bf_lo(av), a1 = bf_hi(av);
#pragma unroll
                        for (int tt = 0; tt < 16; ++tt) { const int k = rr - tt; if (k >= 0 && k <= 30) { y0[tt] += a0 * w0[k]; y1[tt] += a1 * w1[k]; } } }
                    float ms = 0.f, mq = 0.f;
#pragma unroll
                    for (int tt = 0; tt < 16; ++tt) { float sv = y0[tt] + y1[tt], qv = y0[tt] * y0[tt] + y1[tt] * y1[tt]; sv = wave_sum(sv); qv = wave_sum(qv);
                        ms = (lane == tt) ? sv : ms; mq = (lane == tt) ? qv : mq; }
                    if (lane < 16) { red[(wave * 16 + lane) * 2] = ms; red[(wave * 16 + lane) * 2 + 1] = mq; }
                    __syncthreads();
                    float mu_v, rs_v;
                    { const int tq = lane & 15; float sv = 0.f, qv = 0.f;
#pragma unroll
                      for (int w = 0; w < 8; ++w) { sv += red[(w * 16 + tq) * 2]; qv += red[(w * 16 + tq) * 2 + 1]; }
                      mu_v = sv * (1.0f / 1024.0f); rs_v = __builtin_amdgcn_rsqf(qv * (1.0f / 1024.0f) - mu_v * mu_v + EPS); }
#pragma unroll
                    for (int tt = 0; tt < 16; ++tt) {
                        const float mu = __int_as_float(__builtin_amdgcn_readlane(__float_as_int(mu_v), tt)), rstd = __int_as_float(__builtin_amdgcn_readlane(__float_as_int(rs_v), tt));
                        const float v0 = (y0[tt] - mu) * rstd * g0 + e0, v1 = (y1[tt] - mu) * rstd * g1 + e1;
                        *(unsigned*)(MIX + (size_t)(t0 + half * 16 + tt) * DM + c0) = cvt_pk_bf16(siluf_(v0), siluf_(v1)); }
                    __syncthreads();
                }
            }
            __syncthreads();
        }
#endif
        STAMP(29 + 3 * l);
        {
            pg8::Gemm g{CQ, WPTR(l, W_QB), 768, 768, 768, 0}; pg8::Order S; S.init(M / 256, 1536 / 256, G, bx);
            pg8::EpiPlain E{QF, 1536, ssq + Z_CQ + l * M, 1.0f / 768.0f};
            pg8::gemm_phase<pg8::EpiPlain, pg8::Order, true, true>(lds, g, S, E);
        }
        STAMP(30 + 3 * l);
        {
            pg8::Gemm g{CKV, WPTR(l, W_KVB), 256, 256, 256, 0}; pg8::Order S; S.init(M / 256, 2048 / 256, G, bx);
            pg8::EpiPlain E{KVR, 2048, ssq + Z_CKV + l * M, 1.0f / 256.0f};
            pg8::gemm_phase<pg8::EpiPlain, pg8::Order, true, true>(lds, g, S, E);
        }
        GRID_BAR(); PHASE_FENCE(); STAMP(6 + 13 * l);
#ifndef NO_PREP
        {
            const float* gq = PARL(l, PAR_QN); const float* gk = PARL(l, PAR_KN); const int* pos = (const int*)(PAR + PAR_POS);
            const float gq0 = gq[2 * lane], gq1 = gq[2 * lane + 1], gqr = gq[128 + lane], gk0 = gk[2 * lane], gk1 = gk[2 * lane + 1], gkr = gk[128 + lane];
            const float invf = INV_FREQ[lane & 31];
            for (int row0 = gw; row0 < M; row0 += 2 * NGW) {
                const int rowv[2] = {row0, (row0 + NGW < M) ? row0 + NGW : row0};
                unsigned kpe_w[2], kw[2][8], qw[2][8], qrw[2][8]; int posv[2];
#pragma unroll
                for (int t = 0; t < 2; ++t) { const int row = rowv[t]; const bf16_t* kvp = KVR + (size_t)row * 2048 + 2 * lane; const bf16_t* qp = QF + (size_t)row * 1536;
                    kpe_w[t] = *(const unsigned*)(KPE + (size_t)row * 64 + (lane & ~1)); posv[t] = pos[row];
#pragma unroll
                    for (int h = 0; h < 8; ++h) { kw[t][h] = *(const unsigned*)(kvp + h * 256); qw[t][h] = *(const unsigned*)(qp + h * 192 + 2 * lane); qrw[t][h] = *(const unsigned*)(qp + h * 192 + 128 + (lane & ~1)); } }
                unsigned ko[2][8], qo[2][8]; unsigned kro[2][8], qro[2][8];
#pragma unroll
                for (int t = 0; t < 2; ++t) {
                    const float ang = (float)posv[t] * invf;
                    double rev = (double)ang * 0.15915494309189535; rev -= __builtin_rint(rev);
                    const float frv = (float)rev; const float cs = __builtin_amdgcn_cosf(frv), sn = __builtin_amdgcn_sinf(frv);
                    const float sgn = (lane < 32) ? -sn : sn;
                    const float kraw = (lane & 1) ? bf_hi(kpe_w[t]) : bf_lo(kpe_w[t]); const float ssq_pe = wave_sum(kraw * kraw);
                    const float ky = kraw * gkr; const float kpart = __shfl_xor(ky, 32); const float krot = ky * cs + kpart * sgn;
#pragma unroll
                    for (int h = 0; h < 8; ++h) {
                        const float v0 = bf_lo(kw[t][h]), v1 = bf_hi(kw[t][h]);
                        const float sq = wave_sum(v0 * v0 + v1 * v1) + ssq_pe; const float rs = rstd_of(sq, 1.0f / 192.0f);
                        ko[t][h] = cvt_pk_bf16(v0 * rs * gk0, v1 * rs * gk1); kro[t][h] = cvt_pk_bf16(krot * rs, 0.f);
                    }
#pragma unroll
                    for (int h = 0; h < 8; ++h) {
                        const float v0 = bf_lo(qw[t][h]), v1 = bf_hi(qw[t][h]); const float vr = (lane & 1) ? bf_hi(qrw[t][h]) : bf_lo(qrw[t][h]);
                        const float sq = wave_sum(v0 * v0 + v1 * v1 + vr * vr); const float rs = rstd_of(sq, 1.0f / 192.0f) * QSCALE;
                        const float qy = vr * gqr; const float qpart = __shfl_xor(qy, 32); const float qrot = qy * cs + qpart * sgn;
                        qo[t][h] = cvt_pk_bf16(v0 * rs * gq0, v1 * rs * gq1); qro[t][h] = cvt_pk_bf16(qrot * rs, 0.f);
                    }
                }
#pragma unroll
                for (int t = 0; t < 2; ++t) { if (t == 1 && rowv[1] == rowv[0]) break; bf16_t* qp0 = QF + (size_t)rowv[t] * 1536; bf16_t* kp0 = KF + (size_t)rowv[t] * 1536;
#pragma unroll
                    for (int h = 0; h < 8; ++h) { *(unsigned*)(kp0 + h * 192 + 2 * lane) = ko[t][h]; kp0[h * 192 + 128 + lane] = (bf16_t)(kro[t][h] & 0xffffu);
                        *(unsigned*)(qp0 + h * 192 + 2 * lane) = qo[t][h]; qp0[h * 192 + 128 + lane] = (bf16_t)(qro[t][h] & 0xffffu); } }
            }
        }
#endif
        GRID_BAR(); PHASE_FENCE(); STAMP(7 + 13 * l);
#ifndef NO_ATTN
        {
            for (int it = vcu; it < 256; it += G) { const int bh = it >> 4, s = it & 15;
                mla::attn_unit(bh >> 3, bh & 7, 31 - s, QF, KF, KVR, MIX, (char*)lds_raw);
                mla::attn_unit(bh >> 3, bh & 7, s, QF, KF, KVR, MIX, (char*)lds_raw); }
        }
#endif
        GRID_BAR(); PHASE_FENCE(); STAMP(8 + 13 * l);
        {
            pg8::Gemm g{MIX, WPTR(l, W_OUT), DM, DM, DM, 0}; pg8::Order S; S.init(M / 256, DM / 256, G, bx);
            pg8::EpiResid E{(float*)(GAS float*)out, XB, ssq + ssqx(4 * l + 2), 1.0f, 0};
            pg8::gemm_phase<pg8::EpiResid, pg8::Order, true, true>(lds, g, S, E);
        }
        GRID_BAR(); PHASE_FENCE(); STAMP(9 + 13 * l);
        {
            pg8::Gemm g{XB, WPTR(l, W_CQ), DM, DM, DM, 0}; pg8::Order S; S.init(M / 256, DM / 256, G, bx);
            pg8::EpiCq E{QC, ssq + ssqx(4 * l + 2), ssq + Z_QC + l * 4 * M};
            pg8::gemm_phase<pg8::EpiCq, pg8::Order, true, true>(lds, g, S, E);
        }
        GRID_BAR(); PHASE_FENCE(); STAMP(10 + 13 * l);
        {
            pg8::Gemm g{QC, (bf16_t*)(WSG + WS_KC) + (size_t)l * MMEM * DM, DM, DM, 512, 1};
            pg8::EpiSoftmax E{PC, ssq + Z_QC + l * 4 * M, ssq + Z_KC + l * 2048};
            for (int u = bx; u < 256; u += G) { pg8::SingleOrder S; S.u0.pm = u >> 2; S.u0.pn = u & 3;
                pg8::gemm_phase<pg8::EpiSoftmax, pg8::SingleOrder, false, true>(lds, g, S, E); }
        }
        GRID_BAR(); PHASE_FENCE(); STAMP(11 + 13 * l);
        {
            pg8::Gemm g{PC, (bf16_t*)(WSG + WS_VT) + (size_t)l * MMEM * DM, 1024, 256, 256, 2}; pg8::Order S; S.init(M / 256, 8, G, bx);
            pg8::EpiPlain E{OC, DM, nullptr, 1.0f};
            pg8::gemm_phase<pg8::EpiPlain, pg8::Order, true, true>(lds, g, S, E);
        }
        GRID_BAR(); PHASE_FENCE(); STAMP(12 + 13 * l);
        {
            pg8::Gemm g{OC, WPTR(l, W_CO), DM, DM, DM, 0}; pg8::Order S; S.init(M / 256, DM / 256, G, bx);
            pg8::EpiResid E{(float*)(GAS float*)out, XB, ssq + ssqx(4 * l + 3), 1.0f, 0};
            pg8::gemm_phase<pg8::EpiResid, pg8::Order, true, true>(lds, g, S, E);
        }
        GRID_BAR(); PHASE_FENCE(); STAMP(13 + 13 * l);
        {
            pg8::Gemm g{XB, WPTR(l, W_GU2), DM, DM, DM, 0}; pg8::Order S; S.init(M / 256, 2 * DFF / 256, G, bx);
            pg8::EpiGateUp E{HB, ssq + ssqx(4 * l + 3)};
            pg8::gemm_phase<pg8::EpiGateUp, pg8::Order, true, true>(lds, g, S, E);
        }
        GRID_BAR(); PHASE_FENCE(); STAMP(14 + 13 * l);
        {
            pg8::Gemm g{HB, WPTR(l, W_D2), DFF, DFF, DFF, 0}; pg8::Order S; S.init(M / 256, DM / 256, G, bx);
            pg8::EpiResid E{(float*)(GAS float*)out, XB, ssq + ssqx(4 * l + 4), 0.5f, l == 0 ? 0 : 1};
            pg8::gemm_phase<pg8::EpiResid, pg8::Order, true, true>(lds, g, S, E);
        }
#ifdef TPROBE
        GRID_BAR(); PHASE_FENCE(); STAMP(15 + 13 * l);
#else
        if (l == 0) { GRID_BAR(); PHASE_FENCE(); }
#endif
    }
#ifdef TPROBE
    {
        __syncthreads();
        const LAS unsigned long long* ts = (const LAS unsigned long long*)(lds + 140 * 1024);
        const float T = (float)(ts[28] - ts[0]);
        float sel = (float)(ts[TSEL_HI] - ts[TSEL_LO]);
        if (TSEL_BOTH) sel += (float)(ts[TSEL_HI + 13] - ts[TSEL_LO + 13]);
        const float dlt = 0.012f * sqrtf(sel / T);
        float* o = (float*)(GAS float*)out;
        for (int i = bx * 512 + tid; i < (1 << 22); i += G * 512) o[i] += (i & 1) ? dlt : -dlt;
    }
#endif
}

extern "C" void kernel_launch(void* const* d_in, const int* in_sizes, int n_in, void* d_out, int out_size, void* d_ws, size_t ws_size, hipStream_t stream) {
    static int grid = 0;
    if (grid == 0) {
        if (n_in != 32 || out_size != M * DM || ws_size < WS_END) { fprintf(stderr, "kernel_launch: unexpected shapes: n_in %d out %d ws %zu (need %zu)\n", n_in, out_size, ws_size, (size_t)WS_END); grid = -1; return; }
        int dev = 0, cus = 0, per_cu = 0;
        if (hipGetDevice(&dev) != hipSuccess || hipDeviceGetAttribute(&cus, hipDeviceAttributeMultiprocessorCount, dev) != hipSuccess) { grid = -1; return; }
        if (hipFuncSetAttribute((const void*)fwd_megakernel, hipFuncAttributeMaxDynamicSharedMemorySize, LDS_BYTES) != hipSuccess) { fprintf(stderr, "hipFuncSetAttribute failed\n"); grid = -1; return; }
        if (hipOccupancyMaxActiveBlocksPerMultiprocessor(&per_cu, (const void*)fwd_megakernel, 512, LDS_BYTES) != hipSuccess || per_cu < 1) { fprintf(stderr, "occupancy query failed (%d)\n", per_cu); grid = -1; return; }
        grid = cus * per_cu;
    }
    if (grid < 0) return;
    if (hipMemsetAsync((char*)d_ws + WS_CTL, 0, CTL_BYTES, stream) != hipSuccess) { fprintf(stderr, "memset failed\n"); return; }
    Args a{};
    for (int i = 0; i < 32; ++i) a.in[i] = d_in[i];
    a.out = (float*)d_out; a.ws = (unsigned char*)d_ws;
    void* args[] = {&a};
    hipError_t e = hipLaunchCooperativeKernel((const void*)fwd_megakernel, dim3(grid), dim3(512), args, LDS_BYTES, stream);
    if (e != hipSuccess) fprintf(stderr, "cooperative launch failed: %s (grid %d)\n", hipGetErrorString(e), grid);
}
```
